# Optimizing an MI355X kernel written in HIP

```python
import jax, jax.numpy as jnp
from jax import lax
import numpy as np

D_MODEL = 2048
BATCH = 32
SEQ = 256
DEPTH = 4
DEC_BATCH = 4
DEC_SEQ = 4096
PAST_LEN = 512

GRID_W = 64
MLA_HEADS = 8
MLA_NOPE = 128
MLA_ROPE = 64
MLA_QK = MLA_NOPE + MLA_ROPE
MLA_V = 128
MLA_KV_RANK = 512
HG_HEADS = 8
HG_K = 128
HG_V = 128
HG_CHUNK = 32
NA_HEADS = 8
NA_DH = 128
NA_WIN_R = 8
NA_WIN_C = 16
NA_RPB_R = 2 * NA_WIN_R - 1
NA_RPB_C = 2 * NA_WIN_C - 1
N_BRANCH = 3
BRANCH_W = 1024
N_IN = MLA_HEADS * MLA_QK + MLA_KV_RANK + MLA_ROPE + 3 * HG_HEADS * HG_K + 2 * HG_HEADS * HG_V + 3 * NA_HEADS * NA_DH + N_BRANCH * D_MODEL
FFN_DIM = 5632
CONV_W = 3
ROPE_BASE = 10000.0
EPS = 1e-6
Q_BLOCK = 128
NEG = -1e30

kernel_name = 'hybrid_mla_hgrn2_natten_prefix_dit_step'


def _rms_norm(x, g):
    xf = x.astype(jnp.float32)
    y = xf * lax.rsqrt(jnp.mean(xf * xf, axis=-1, keepdims=True) + EPS)
    return (y * g.astype(jnp.float32)).astype(x.dtype)


def _split_in(z):
    sizes = (MLA_HEADS * MLA_QK, MLA_KV_RANK, MLA_ROPE,
             HG_HEADS * HG_K, HG_HEADS * HG_K, HG_HEADS * HG_K, HG_HEADS * HG_V, HG_HEADS * HG_V,
             NA_HEADS * NA_DH, NA_HEADS * NA_DH, NA_HEADS * NA_DH,
             D_MODEL, D_MODEL, D_MODEL)
    bounds = np.cumsum(np.array(sizes))[:-1].tolist()
    return jnp.split(z, bounds, axis=-1)


def _modulation(cond, w, b):
    m = jax.nn.silu(cond) @ w + b
    return jnp.split(m[:, None, :], 6, axis=-1)


def _rope_angles(T):
    t = jnp.arange(T, dtype=jnp.int32)
    n_freq = MLA_ROPE // 4
    inv = ROPE_BASE ** (-jnp.arange(n_freq, dtype=jnp.float32) / n_freq)
    row = (t // GRID_W).astype(jnp.float32)
    col = (t % GRID_W).astype(jnp.float32)
    return row[:, None] * inv, col[:, None] * inv


def _rotate_half(x, ang):
    n = ang.shape[-1]
    cos = jnp.cos(ang)[:, None, :].astype(x.dtype)
    sin = jnp.sin(ang)[:, None, :].astype(x.dtype)
    x1, x2 = x[..., :n], x[..., n:]
    return jnp.concatenate([x1 * cos - x2 * sin, x1 * sin + x2 * cos], axis=-1)


def _axial_rope(x, ang_r, ang_c):
    h = x.shape[-1] // 2
    return jnp.concatenate([_rotate_half(x[..., :h], ang_r), _rotate_half(x[..., h:], ang_c)], axis=-1)


def _blocked_attention(q, k, v, scale):
    B, T, H, dq = q.shape
    nb = T // Q_BLOCK
    qb = q.reshape(B, nb, Q_BLOCK, H, dq).transpose(1, 0, 2, 3, 4)

    def one(qi):
        s = jnp.einsum('bqhd,bkhd->bhqk', qi, k).astype(jnp.float32) * scale
        p = jax.nn.softmax(s, axis=-1).astype(v.dtype)
        return jnp.einsum('bhqk,bkhd->bqhd', p, v)

    o = lax.map(one, qb)
    return o.transpose(1, 0, 2, 3, 4).reshape(B, T, H, v.shape[-1])


def _mla_kv(ckv, kpe, w_uk, w_uv, k_g):
    k_nope = jnp.einsum('bsr,rhd->bshd', ckv, w_uk)
    k_pe = jnp.broadcast_to(kpe[:, :, None, :], kpe.shape[:2] + (w_uk.shape[1], kpe.shape[-1]))
    k = _rms_norm(jnp.concatenate([k_nope, k_pe], axis=-1), k_g)
    v = jnp.einsum('bsr,rhd->bshd', ckv, w_uv)
    return k, v


def _hgrn_gates(f_raw, lb):
    x32 = f_raw.astype(jnp.float32)
    log_f = jnp.logaddexp(jnp.log(lb), jnp.log1p(-lb) + jax.nn.log_sigmoid(x32))
    k = (1.0 - lb) * jax.nn.sigmoid(-x32)
    return log_f, k


def _hgrn_scan(q, k, v, log_f, s0):
    B, T, H, K = q.shape
    V = v.shape[-1]
    n = T // HG_CHUNK

    def chunks(a):
        return a.reshape(B, n, HG_CHUNK, H, a.shape[-1]).transpose(1, 0, 3, 2, 4)

    causal = jnp.tril(jnp.ones((HG_CHUNK, HG_CHUNK), dtype=bool))[:, :, None]

    def step(S, inp):
        qi, ki, vi, fi = inp
        qf = qi.astype(jnp.float32)
        vf = vi.astype(jnp.float32)
        b = jnp.cumsum(fi, axis=2)
        diff = b[:, :, :, None, :] - b[:, :, None, :, :]
        decay = jnp.exp(jnp.where(causal, diff, -jnp.inf))
        attn = jnp.einsum('bhtk,bhsk,bhtsk->bhts', qf, ki, decay)
        o = jnp.einsum('bhts,bhsv->bhtv', attn, vf) + jnp.einsum('bhtk,bhkv->bhtv', qf * jnp.exp(b), S)
        b_last = b[:, :, -1:, :]
        S_new = jnp.exp(b_last[:, :, 0, :])[..., None] * S + jnp.einsum('bhsk,bhsv->bhkv', ki * jnp.exp(b_last - b), vf)
        return S_new, o

    sT, o = lax.scan(step, s0.astype(jnp.float32), (chunks(q), chunks(k), chunks(v), chunks(log_f)))
    o = o.transpose(1, 0, 3, 2, 4).reshape(B, T, H, V)
    return o.astype(v.dtype), sT.astype(v.dtype)


def _hgrn_branch(hq, hff, hfb, hi, hg, lb_f, lb_b, s0_f, s0_b, norm_g):
    B, T = hq.shape[:2]
    q = jax.nn.silu(hq).reshape(B, T, HG_HEADS, HG_K)
    v = hi.reshape(B, T, HG_HEADS, HG_V)
    lf_f, k_f = _hgrn_gates(hff.reshape(B, T, HG_HEADS, HG_K), lb_f.reshape(HG_HEADS, HG_K))
    lf_b, k_b = _hgrn_gates(hfb.reshape(B, T, HG_HEADS, HG_K), lb_b.reshape(HG_HEADS, HG_K))
    o_f, s_f = _hgrn_scan(q, k_f, v, lf_f, s0_f)
    o_b, s_b = _hgrn_scan(q[:, ::-1], k_b[:, ::-1], v[:, ::-1], lf_b[:, ::-1], s0_b)
    o = o_f + o_b[:, ::-1]
    o = _rms_norm(o, norm_g) * jax.nn.silu(hg.reshape(B, T, HG_HEADS, HG_V))
    return o.reshape(B, T, HG_HEADS * HG_V), jnp.stack([s_f, s_b], axis=1)


def _neighborhood_attention(q, k, v, k_ctx, v_ctx, rpb, scale):
    B, T, H, Dh = q.shape
    rows = T // GRID_W
    wr = min(NA_WIN_R, rows)
    wc = NA_WIN_C
    qr = q.reshape(B, rows, GRID_W, H, Dh)
    kr = k.reshape(B, rows, GRID_W, H, Dh)
    vr = v.reshape(B, rows, GRID_W, H, Dh)
    qcol = jnp.arange(GRID_W)
    cs = jnp.clip(qcol - wc // 2, 0, GRID_W - wc)
    in_win = (qcol[None, :] >= cs[:, None]) & (qcol[None, :] < cs[:, None] + wc)
    dc_idx = jnp.clip(qcol[None, :] - qcol[:, None], -(wc - 1), wc - 1) + (NA_WIN_C - 1)
    n_loc = wr * GRID_W

    def row_block(r):
        rs = jnp.clip(r - NA_WIN_R // 2, 0, rows - wr)
        kb = lax.dynamic_slice_in_dim(kr, rs, wr, axis=1)
        vb = lax.dynamic_slice_in_dim(vr, rs, wr, axis=1)
        qb = lax.dynamic_index_in_dim(qr, r, axis=1, keepdims=False)
        dr_idx = rs + jnp.arange(wr) - r + (NA_WIN_R - 1)
        bias = rpb[:, dr_idx[None, :, None], dc_idx[:, None, :]].astype(jnp.float32)
        s_loc = jnp.einsum('bqhd,bikhd->bhqik', qb, kb).astype(jnp.float32) * scale + bias
        s_loc = jnp.where(in_win[:, None, :], s_loc, NEG).reshape(B, H, GRID_W, n_loc)
        s_ctx = jnp.einsum('bqhd,bphd->bhqp', qb, k_ctx).astype(jnp.float32) * scale
        p = jax.nn.softmax(jnp.concatenate([s_loc, s_ctx], axis=-1), axis=-1).astype(v.dtype)
        p_loc = p[..., :n_loc].reshape(B, H, GRID_W, wr, GRID_W)
        p_ctx = p[..., n_loc:]
        return jnp.einsum('bhqik,bikhd->bqhd', p_loc, vb) + jnp.einsum('bhqp,bphd->bqhd', p_ctx, v_ctx)

    out = lax.map(row_block, jnp.arange(rows))
    return out.transpose(1, 0, 2, 3, 4).reshape(B, T, H, Dh)


def _merge(o_mla, o_hg, o_na, ga, gb, gc, w_branch, w_out):
    m = (jax.nn.sigmoid(ga) * (o_mla @ w_branch[0])
         + jax.nn.sigmoid(gb) * (o_hg @ w_branch[1])
         + jax.nn.sigmoid(gc) * (o_na @ w_branch[2]))
    return m @ w_out


def _conv_ffn(h, w_up, conv_w, conv_b, w_down):
    a, g = jnp.split(h @ w_up, 2, axis=-1)
    gp = jnp.pad(g, ((0, 0), (1, 1), (0, 0)))
    g = gp[:, :-2] * conv_w[0] + gp[:, 1:-1] * conv_w[1] + gp[:, 2:] * conv_w[2] + conv_b
    return (jax.nn.silu(g) * a) @ w_down


def _context_layer(x, mod, lp, lb_f, lb_b):
    sh1, sc1, g1, sh2, sc2, g2 = mod
    B, S, _ = x.shape
    h = _rms_norm(x, lp['norm1_g']) * (1.0 + sc1) + sh1
    (mq, ckv_raw, kpe, hq, hff, hfb, hi, hg, nq, nk, nv, ga, gb, gc) = _split_in(h @ lp['w_in'])
    q = _rms_norm(mq.reshape(B, S, MLA_HEADS, MLA_QK), lp['mla_q_g'])
    ckv = _rms_norm(ckv_raw, lp['mla_kv_g'])
    k, v = _mla_kv(ckv, kpe, lp['mla_w_uk'], lp['mla_w_uv'], lp['mla_k_g'])
    o_mla = _blocked_attention(q, k, v, MLA_QK ** -0.5).reshape(B, S, MLA_HEADS * MLA_V)
    zeros = jnp.zeros((B, HG_HEADS, HG_K, HG_V), jnp.float32)
    o_hg, s_hg = _hgrn_branch(hq, hff, hfb, hi, hg, lb_f, lb_b, zeros, zeros, lp['hg_norm_g'])
    nqh = _rms_norm(nq.reshape(B, S, NA_HEADS, NA_DH), lp['na_q_g'])
    nkh = _rms_norm(nk.reshape(B, S, NA_HEADS, NA_DH), lp['na_k_g'])
    nvh = nv.reshape(B, S, NA_HEADS, NA_DH)
    o_na = _blocked_attention(nqh, nkh, nvh, NA_DH ** -0.5).reshape(B, S, NA_HEADS * NA_DH)
    x = x + g1 * _merge(o_mla, o_hg, o_na, ga, gb, gc, lp['w_branch'], lp['w_out'])
    h2 = _rms_norm(x, lp['norm2_g']) * (1.0 + sc2) + sh2
    x = x + g2 * _conv_ffn(h2, lp['ffn_w_up'], lp['ffn_conv_w'], lp['ffn_conv_b'], lp['ffn_w_down'])
    return x, (ckv, kpe, nkh, nvh, s_hg)


def _latent_layer(x, mod, lp, lb_f, lb_b, ckv_c, kpe_c, nk_c, nv_c, s_c, ang_r, ang_c):
    sh1, sc1, g1, sh2, sc2, g2 = mod
    B, T, _ = x.shape
    h = _rms_norm(x, lp['norm1_g']) * (1.0 + sc1) + sh1
    (mq, ckv_raw, kpe, hq, hff, hfb, hi, hg, nq, nk, nv, ga, gb, gc) = _split_in(h @ lp['w_in'])
    q = _rms_norm(mq.reshape(B, T, MLA_HEADS, MLA_QK), lp['mla_q_g'])
    q = jnp.concatenate([q[..., :MLA_NOPE], _axial_rope(q[..., MLA_NOPE:], ang_r, ang_c)], axis=-1)
    k_l, v_l = _mla_kv(_rms_norm(ckv_raw, lp['mla_kv_g']), kpe, lp['mla_w_uk'], lp['mla_w_uv'], lp['mla_k_g'])
    k_l = jnp.concatenate([k_l[..., :MLA_NOPE], _axial_rope(k_l[..., MLA_NOPE:], ang_r, ang_c)], axis=-1)
    k_c, v_c = _mla_kv(ckv_c, kpe_c, lp['mla_w_uk'], lp['mla_w_uv'], lp['mla_k_g'])
    o_mla = _blocked_attention(q, jnp.concatenate([k_l, k_c], axis=1), jnp.concatenate([v_l, v_c], axis=1),
                               MLA_QK ** -0.5).reshape(B, T, MLA_HEADS * MLA_V)
    o_hg, _ = _hgrn_branch(hq, hff, hfb, hi, hg, lb_f, lb_b, s_c[:, 0], s_c[:, 1], lp['hg_norm_g'])
    nqh = _rms_norm(nq.reshape(B, T, NA_HEADS, NA_DH), lp['na_q_g'])
    nkh = _rms_norm(nk.reshape(B, T, NA_HEADS, NA_DH), lp['na_k_g'])
    nvh = nv.reshape(B, T, NA_HEADS, NA_DH)
    o_na = _neighborhood_attention(nqh, nkh, nvh, nk_c, nv_c, lp['na_rpb'], NA_DH ** -0.5).reshape(B, T, NA_HEADS * NA_DH)
    x = x + g1 * _merge(o_mla, o_hg, o_na, ga, gb, gc, lp['w_branch'], lp['w_out'])
    h2 = _rms_norm(x, lp['norm2_g']) * (1.0 + sc2) + sh2
    return x + g2 * _conv_ffn(h2, lp['ffn_w_up'], lp['ffn_conv_w'], lp['ffn_conv_b'], lp['ffn_w_down'])


def setup_inputs(seed: int = 0) -> dict:
    key = jax.random.key(seed)
    ks = jax.random.split(key, 32)
    D = D_MODEL

    def nrm(k, shape, scale):
        return jax.random.normal(k, shape, jnp.float32) * scale

    def gain(k, shape):
        return 1.0 + 0.05 * jax.random.normal(k, shape, jnp.float32)

    return {
        'x_prompt': nrm(ks[0], (BATCH, SEQ, D), 1.0),
        'x_sample': nrm(ks[1], (DEC_BATCH, DEC_SEQ, D), 1.0),
        'cache_mla_ckv': nrm(ks[2], (DEC_BATCH, DEPTH, PAST_LEN, MLA_KV_RANK), 1.0),
        'cache_mla_kpe': nrm(ks[3], (DEC_BATCH, DEPTH, PAST_LEN, MLA_ROPE), 1.0),
        'cache_na_k': nrm(ks[4], (DEC_BATCH, DEPTH, PAST_LEN, NA_HEADS, NA_DH), 1.0),
        'cache_na_v': nrm(ks[5], (DEC_BATCH, DEPTH, PAST_LEN, NA_HEADS, NA_DH), 1.0),
        'state_hgrn': nrm(ks[6], (DEC_BATCH, DEPTH, 2, HG_HEADS, HG_K, HG_V), 0.5),
        'c': nrm(ks[7], (DEC_BATCH, D), 1.0),
        'c_ctx': nrm(ks[8], (D,), 1.0),
        'w_mod': nrm(ks[9], (DEPTH, D, 6 * D), 0.5 * D ** -0.5),
        'b_mod': nrm(ks[10], (DEPTH, 6 * D), 0.01),
        'norm1_g': gain(ks[11], (DEPTH, D)),
        'norm2_g': gain(ks[12], (DEPTH, D)),
        'w_in': nrm(ks[13], (DEPTH, D, N_IN), D ** -0.5),
        'mla_kv_norm_g': gain(ks[14], (DEPTH, MLA_KV_RANK)),
        'mla_q_norm_g': gain(ks[15], (DEPTH, MLA_QK)),
        'mla_k_norm_g': gain(ks[16], (DEPTH, MLA_QK)),
        'mla_w_uk': nrm(ks[17], (DEPTH, MLA_KV_RANK, MLA_HEADS, MLA_NOPE), MLA_KV_RANK ** -0.5),
        'mla_w_uv': nrm(ks[18], (DEPTH, MLA_KV_RANK, MLA_HEADS, MLA_V), MLA_KV_RANK ** -0.5),
        'hgrn_lower_bounds': nrm(ks[19], (2, DEPTH, HG_HEADS * HG_K), 1.0),
        'hgrn_norm_g': gain(ks[20], (DEPTH, HG_V)),
        'na_q_norm_g': gain(ks[21], (DEPTH, NA_DH)),
        'na_k_norm_g': gain(ks[22], (DEPTH, NA_DH)),
        'na_rpb': nrm(ks[23], (DEPTH, NA_HEADS, NA_RPB_R, NA_RPB_C), 0.2),
        'w_branch': nrm(ks[24], (DEPTH, N_BRANCH, BRANCH_W, D), BRANCH_W ** -0.5),
        'w_out': nrm(ks[25], (DEPTH, D, D), D ** -0.5),
        'ffn_w_up': nrm(ks[26], (DEPTH, D, 2 * FFN_DIM), D ** -0.5),
        'ffn_conv_w': nrm(ks[27], (DEPTH, CONV_W, FFN_DIM), CONV_W ** -0.5),
        'ffn_conv_b': nrm(ks[28], (DEPTH, FFN_DIM), 0.01),
        'ffn_w_down': nrm(ks[29], (DEPTH, FFN_DIM, D), FFN_DIM ** -0.5),
    }


def reference(x_prompt, x_sample, cache_mla_ckv, cache_mla_kpe, cache_na_k, cache_na_v, state_hgrn, c, c_ctx,
              w_mod, b_mod, norm1_g, norm2_g, w_in, mla_kv_norm_g, mla_q_norm_g, mla_k_norm_g, mla_w_uk, mla_w_uv,
              hgrn_lower_bounds, hgrn_norm_g, na_q_norm_g, na_k_norm_g, na_rpb, w_branch, w_out,
              ffn_w_up, ffn_conv_w, ffn_conv_b, ffn_w_down):
    sm = jax.nn.softmax(hgrn_lower_bounds.astype(jnp.float32), axis=1)
    cs = jnp.cumsum(sm, axis=1)
    lower = cs - cs[:, :1]
    ang_r, ang_c = _rope_angles(x_sample.shape[1])
    xp, xs = x_prompt, x_sample
    ckv_l, kpe_l, nk_l, nv_l, hg_l = [], [], [], [], []
    for l in range(DEPTH):
        lp = {
            'norm1_g': norm1_g[l], 'norm2_g': norm2_g[l], 'w_in': w_in[l],
            'mla_kv_g': mla_kv_norm_g[l], 'mla_q_g': mla_q_norm_g[l], 'mla_k_g': mla_k_norm_g[l],
            'mla_w_uk': mla_w_uk[l], 'mla_w_uv': mla_w_uv[l], 'hg_norm_g': hgrn_norm_g[l],
            'na_q_g': na_q_norm_g[l], 'na_k_g': na_k_norm_g[l], 'na_rpb': na_rpb[l],
            'w_branch': w_branch[l], 'w_out': w_out[l], 'ffn_w_up': ffn_w_up[l],
            'ffn_conv_w': ffn_conv_w[l], 'ffn_conv_b': ffn_conv_b[l], 'ffn_w_down': ffn_w_down[l],
        }
        mod_ctx = _modulation(c_ctx[None, :], w_mod[l], b_mod[l])
        mod_lat = _modulation(c, w_mod[l], b_mod[l])
        xp, (ckv, kpe, nkh, nvh, s_hg) = _context_layer(xp, mod_ctx, lp, lower[0, l], lower[1, l])
        ckv_l.append(ckv)
        kpe_l.append(kpe)
        nk_l.append(nkh)
        nv_l.append(nvh)
        hg_l.append(s_hg)
        xs = _latent_layer(xs, mod_lat, lp, lower[0, l], lower[1, l], cache_mla_ckv[:, l], cache_mla_kpe[:, l],
                           cache_na_k[:, l], cache_na_v[:, l], state_hgrn[:, l], ang_r, ang_c)
    state_mla_ckv = jnp.stack(ckv_l, axis=1)
    state_mla_kpe = jnp.stack(kpe_l, axis=1)
    state_na_k = jnp.stack(nk_l, axis=1)
    state_na_v = jnp.stack(nv_l, axis=1)
    new_state_hgrn = jnp.stack(hg_l, axis=1)
    return (xp, xs, state_mla_ckv, state_mla_kpe, state_na_k, state_na_v, new_state_hgrn)
```

```cpp
#include <hip/hip_runtime.h>
#include <cstdio>
#include <cstdint>

constexpr int DM = 2048;
constexpr int NTC = 8192, NTL = 16384, NTOK = NTC + NTL;
constexpr int NCACHE = 2048;
constexpr int NKV = NTOK + NCACHE;
constexpr int DEPTH = 4;
constexpr int LDZ = 16640;
constexpr int NIN_SRC = 16448;
constexpr int FFN = 5632, FFN2 = 11264;
constexpr int ZC_MQ = 0, ZC_CKV = 1536, ZC_HQ = 2048, ZC_HFF = 3072, ZC_HFB = 4096, ZC_HI = 5120, ZC_HG = 6144,
              ZC_NQ = 7168, ZC_NK = 8192, ZC_NV = 9216, ZC_GA = 10240, ZC_GB = 12288, ZC_GC = 14336;
constexpr int NZ = 16384;
constexpr int ZC_OF = ZC_HQ, ZC_OB = ZC_HFF, ZC_OMLA = ZC_HFB, ZC_ONA = ZC_HI, ZC_OHG = ZC_HG;
constexpr float EPS = 1e-6f;

typedef unsigned short bf16_t;
typedef short bf16x8 __attribute__((ext_vector_type(8)));
typedef short s16x4 __attribute__((ext_vector_type(4)));
typedef float f32x4 __attribute__((ext_vector_type(4)));
typedef float f32x2 __attribute__((ext_vector_type(2)));
typedef float f32x8 __attribute__((ext_vector_type(8)));
typedef float f32x16 __attribute__((ext_vector_type(16)));
typedef unsigned u32x4 __attribute__((ext_vector_type(4)));
typedef unsigned u32x2 __attribute__((ext_vector_type(2)));
typedef __bf16 bfv2 __attribute__((ext_vector_type(2)));

#define DI __device__ __forceinline__
#define LAS __attribute__((address_space(3)))

DI unsigned pk2(float lo, float hi) { f32x2 v = {lo, hi}; bfv2 r = __builtin_convertvector(v, bfv2); return __builtin_bit_cast(unsigned, r); }
DI bf16_t f2bf(float x) { return (bf16_t)(pk2(x, 0.f) & 0xffffu); }
DI float bf2f(bf16_t b) { return __uint_as_float(((unsigned)b) << 16); }
DI float bflo(unsigned w) { return __uint_as_float(w << 16); }
DI float bfhi(unsigned w) { return __uint_as_float(w & 0xffff0000u); }
DI float shfl_xor_l(float v, int o, int lane) { return __builtin_bit_cast(float, __builtin_amdgcn_ds_bpermute((lane ^ o) << 2, __builtin_bit_cast(int, v))); }
DI float wave_sum(float v, int lane) {
#pragma unroll
    for (int o = 32; o >= 1; o >>= 1) v += shfl_xor_l(v, o, lane);
    return v; }
template <int CTRL> DI float dpp_f(float v) { return __builtin_bit_cast(float, __builtin_amdgcn_update_dpp(0, __builtin_bit_cast(int, v), CTRL, 0xF, 0xF, true)); }
DI float group16_sum(float v) { v += dpp_f<0xB1>(v); v += dpp_f<0x4E>(v); v += dpp_f<0x141>(v); v += dpp_f<0x140>(v); return v; }
DI float wave_sum16(float v, int lane) { v = group16_sum(v); v += shfl_xor_l(v, 16, lane); v += shfl_xor_l(v, 32, lane); return v; }
DI void unpack8(const u32x4 w, float (&f)[8]) { f[0] = bflo(w.x); f[1] = bfhi(w.x); f[2] = bflo(w.y); f[3] = bfhi(w.y); f[4] = bflo(w.z); f[5] = bfhi(w.z); f[6] = bflo(w.w); f[7] = bfhi(w.w); }
DI u32x4 pack8f(const float (&f)[8]) { u32x4 w; w.x = pk2(f[0], f[1]); w.y = pk2(f[2], f[3]); w.z = pk2(f[4], f[5]); w.w = pk2(f[6], f[7]); return w; }
DI float sigmoidf_(float x) { return 1.0f / (1.0f + __expf(-x)); }

constexpr size_t al256(size_t x) { return (x + 255) / 256 * 256; }
constexpr size_t WS_CTL = 0;
constexpr size_t CTL_BYTES = 65536;
constexpr size_t WS_MOD = WS_CTL + CTL_BYTES;
constexpr size_t WS_LOWER = WS_MOD + al256((size_t)DEPTH * 5 * 6 * DM * 4);
constexpr size_t WS_ROPE = WS_LOWER + al256(2 * 4 * 1024 * 4);
constexpr size_t WS_WT = WS_ROPE + al256(2 * 64 * 16 * 4);
constexpr size_t WL_IN = 0;
constexpr size_t WL_KV = WL_IN + (size_t)LDZ * DM * 2;
constexpr size_t WL_BR = WL_KV + (size_t)2048 * 512 * 2;
constexpr size_t WL_OUT = WL_BR + (size_t)3 * DM * 1024 * 2;
constexpr size_t WL_UP = WL_OUT + (size_t)DM * DM * 2;
constexpr size_t WL_DN = WL_UP + (size_t)FFN2 * DM * 2;
constexpr size_t WL_KPE = WL_DN + (size_t)DM * FFN * 2;
constexpr size_t WL_BYTES = WL_KPE + (size_t)64 * DM * 2;
constexpr int WT_SLOTS = 2;
constexpr size_t WS_NAKC = WS_WT + (size_t)WT_SLOTS * WL_BYTES;
constexpr size_t WS_NAVC = WS_NAKC + (size_t)DEPTH * 4 * 512 * 1024 * 2;
constexpr size_t WS_H = WS_NAVC + (size_t)DEPTH * 4 * 512 * 1024 * 2;
constexpr size_t WS_Z = WS_H + (size_t)NTOK * DM * 2;
constexpr size_t WS_KVRAW = WS_Z + (size_t)NTOK * LDZ * 2;
constexpr size_t WS_CKVN = WS_KVRAW + (size_t)NKV * 2048 * 2;
constexpr size_t WS_KBUF = WS_CKVN + (size_t)NKV * 512 * 2;
constexpr size_t WS_MACC = WS_KVRAW;
constexpr size_t WS_HG = WS_KBUF + (size_t)NKV * 1536 * 2;
constexpr size_t HG_ARR = (size_t)NTOK * 1024 * 2;
constexpr size_t HG_QTF = 0, HG_KTF = HG_ARR, HG_KTTF = 2 * HG_ARR, HG_QTB = 3 * HG_ARR, HG_KTB = 4 * HG_ARR, HG_KTTB = 5 * HG_ARR, HG_VT = 6 * HG_ARR;
constexpr size_t HG_EV = 7 * HG_ARR;
constexpr size_t HG_BYTES = HG_EV + (size_t)768 * 8 * 2 * 2 * 128 * 4;
constexpr size_t WS_ACT = WS_HG;
constexpr size_t WS_OBR = WS_HG + HG_BYTES;
constexpr int LDO = 3072;
constexpr int LDS_STAGE = 135168;
constexpr int QSLOT_OFF = LDS_STAGE + 64;
constexpr size_t WS_EDGE = WS_KVRAW;
constexpr size_t WS_KPE = WS_OBR + (size_t)NTOK * LDO * 2;
constexpr size_t WS_XB = WS_KPE + (size_t)NTOK * 64 * 2;
constexpr size_t WS_END = WS_XB + (size_t)NTOK * DM * 2;
static_assert((size_t)192 * 2 * 3 * FFN * 4 <= (size_t)NKV * 2048 * 2, "EDGE alias");
static_assert((size_t)NTOK * DM * 4 <= (size_t)NKV * (2048 + 512 + 1536) * 2, "MACC alias");
static_assert((size_t)NTOK * FFN * 2 <= HG_BYTES, "ACT alias");

#define XB_TMO      128
#define XB_XCNT(j)  (256  + 64 * (j))
#define XB_XSUB(j)  (1280 + 64 * (j))
#define XB_XGEN(j)  (2304 + 64 * (j))
#define XB_TOP      3328
#define XB_TOPGEN   3392
#define XCD_BAR_WORDS 3456
#define XB_SPIN_CAP (1u << 23)

DI unsigned xb_ld(unsigned* p)              { return __hip_atomic_load(p, __ATOMIC_RELAXED, __HIP_MEMORY_SCOPE_AGENT); }
DI unsigned xb_add(unsigned* p, unsigned v) { return __hip_atomic_fetch_add(p, v, __ATOMIC_RELAXED, __HIP_MEMORY_SCOPE_AGENT); }
DI unsigned xb_xcc_id() { return (unsigned)__builtin_amdgcn_s_getreg((3 << 11) | 20) & 0xFu; }
#define XB_SPIN(cond, bar) do { unsigned _sp = 0; while (cond) { __builtin_amdgcn_s_sleep(1); \
    if ((++_sp & 255u) == 0u) { if (xb_ld(&(bar)[XB_TMO])) break; if (_sp > XB_SPIN_CAP) { atomicAdd(&(bar)[XB_TMO], 1u); break; } } } } while (0)

struct XcdBarrier { unsigned* bar; unsigned x; volatile LAS unsigned* st; };

DI XcdBarrier xcd_barrier_post(unsigned* bar, volatile LAS unsigned* st) {
    XcdBarrier b; b.bar = bar; b.x = xb_xcc_id(); b.st = st;
    if (threadIdx.x == 0) (void)xb_add(&bar[XB_XCNT(b.x)], 1u);
    return b;
}
DI void xcd_barrier_complete(unsigned* bar, unsigned x, unsigned& nloc, unsigned& nx) {
    const unsigned G = gridDim.x * gridDim.y * gridDim.z;
    unsigned sum, cnt, mine, sp = 0u;
    for (;;) {
        sum = 0u; cnt = 0u; mine = 0u;
#pragma unroll
        for (unsigned j = 0; j < 16; ++j) { const unsigned c = xb_ld(&bar[XB_XCNT(j)]); sum += c; cnt += (c > 0u) ? 1u : 0u; mine = (j == x) ? c : mine; }
        if (sum == G) break;
        __builtin_amdgcn_s_sleep(1);
        if ((++sp & 255u) == 0u) { if (xb_ld(&bar[XB_TMO])) break; if (sp > XB_SPIN_CAP) { atomicAdd(&bar[XB_TMO], 1u); break; } }
    }
    nloc = mine > 0u ? mine : 1u; nx = cnt > 0u ? cnt : 1u;
}
DI void xcd_barrier(const XcdBarrier& b) {
    asm volatile("s_waitcnt vmcnt(0)" ::: "memory");
    __syncthreads();
    if (threadIdx.x == 0) {
        __attribute__((address_space(1))) unsigned* gbar_ = (__attribute__((address_space(1))) unsigned*)b.bar; asm volatile("" : "+v"(gbar_)); unsigned* bar = (unsigned*)gbar_;
        __builtin_amdgcn_s_waitcnt(0);
        unsigned nloc = b.st[0], nx = b.st[1];
        if (nloc == 0u) { xcd_barrier_complete(bar, b.x, nloc, nx); b.st[0] = nloc; b.st[1] = nx; }
        const unsigned old = xb_add(&bar[XB_XSUB(b.x)], 1u);
        const unsigned gen = old / nloc;
        if (old + 1u == (gen + 1u) * nloc) {
            __builtin_amdgcn_fence(__ATOMIC_RELEASE, "agent");
            asm volatile("s_waitcnt vmcnt(0)" ::: "memory");
            const unsigned og = xb_add(&bar[XB_TOP], 1u);
            const unsigned tg = og / nx;
            if (og + 1u == (tg + 1u) * nx) xb_add(&bar[XB_TOPGEN], 1u);
            else XB_SPIN(xb_ld(&bar[XB_TOPGEN]) == tg, bar);
            __builtin_amdgcn_fence(__ATOMIC_ACQUIRE, "agent");
            xb_add(&bar[XB_XGEN(b.x)], 1u);
            asm volatile("s_waitcnt vmcnt(0)" ::: "memory");
        } else {
            XB_SPIN(xb_ld(&bar[XB_XGEN(b.x)]) == gen, bar);
            __builtin_amdgcn_fence(__ATOMIC_ACQUIRE, "agent");
            asm volatile("s_waitcnt vmcnt(0)" ::: "memory");
        }
    }
    __syncthreads();
}
namespace pg8 {
constexpr int BM = 256, BK = 64, HALF = 128, HTB = HALF * BK * 2, STAGE_BYTES = 8 * HTB, NXCD = 8, WGM = 4;

__host__ __device__ __forceinline__ int lds_byte(int r, int c) { const int st = (r >> 4) * 2 + (c >> 5), rr = r & 15, cc = c & 31, ob = rr * 64 + cc * 2; return st * 1024 + (ob ^ (((ob >> 9) & 1) << 5)); }
__host__ __device__ __forceinline__ void stage_rc(int b, int& R, int& C) { const int st = b / 1024, sb = b % 1024, swz = sb ^ (((sb >> 9) & 1) << 5); R = (st >> 1) * 16 + swz / 64; C = (st & 1) * 32 + (swz % 64) / 2; }
__host__ __device__ __forceinline__ int perm32(int rho) { const int n = rho >> 4, i = rho & 15; return 8 * (i >> 2) + 4 * n + (i & 3); }

struct Unit { int pm, pn; };
struct Gemm { const bf16_t* A; const bf16_t* Bt; int M, N, K, lda; };

struct StaticOrder {
    int nM, nN, nwg, G, c;
    __host__ __device__ void init(int M, int N, int G_, int c_) { nM = M / BM; nN = N / BM; nwg = nM * nN; G = G_; c = c_; }
    __host__ __device__ bool next(int i, Unit& u) const {
        const long L = (long)i * G + c; if (L >= nwg) return false;
        int wgid = (int)L; { const int q = nwg / NXCD, r = nwg % NXCD, xcd = wgid % NXCD, off = wgid / NXCD; wgid = (xcd < r ? xcd * (q + 1) : r * (q + 1) + (xcd - r) * q) + off; }
        const int nig = WGM * nN, gid = wgid / nig, fm = gid * WGM, gsz = (nM - fm) < WGM ? (nM - fm) : WGM;
        u.pm = fm + ((wgid % nig) % gsz); u.pn = (wgid % nig) / gsz; return true;
    }
    __device__ __forceinline__ void a_ready(const Unit&) const {}
    __device__ __forceinline__ void done(const Unit&) const {}
};

template <bool NT> struct EpiStoreBf16T {
    static constexpr bool PERM = true; static constexpr int MIDK = 0; static constexpr bool AROWPERM = false; static constexpr bool BJADJ = true;
    bf16_t* O; int ldc;
    __device__ __forceinline__ void operator()(const f32x4 (&acc)[2][2][4][2], const Unit& u, int wr, int wc, int fr, int fq) const {
        const int row0 = u.pm * BM + wr * 64 + fr, col0 = u.pn * BM + wc * 64 + 8 * fq;
#pragma unroll
        for (int ai = 0; ai < 2; ++ai)
#pragma unroll
            for (int m = 0; m < 4; ++m) { bf16_t* rowp = O + (size_t)(row0 + ai * HALF + m * 16) * ldc + col0;
#pragma unroll
                for (int bj = 0; bj < 2; ++bj) { const f32x4 v0 = acc[ai][bj][m][0], v1 = acc[ai][bj][m][1];
                    u32x4 w; w.x = pk2(v0[0], v0[1]); w.y = pk2(v0[2], v0[3]); w.z = pk2(v1[0], v1[1]); w.w = pk2(v1[2], v1[3]);
                    if (NT) __builtin_nontemporal_store(w, (u32x4*)(rowp + bj * 32)); else *(u32x4*)(rowp + bj * 32) = w; } }
    }
};
typedef EpiStoreBf16T<true> EpiStoreBf16;
struct EpiGate3 {
    static constexpr bool PERM = true; static constexpr int MIDK = 16; static constexpr bool AROWPERM = false; static constexpr bool BJADJ = false;
    const bf16_t* gate; int ldg;
    bf16_t* mout;
    static __device__ __forceinline__ float ratio(float a, float b) { return (1.0f + __expf(-b)) * __builtin_amdgcn_rcpf(1.0f + __expf(-a)); }
    __device__ __forceinline__ void mid(f32x4 (&acc)[2][2][4][2], const Unit& u, int seg, int wr, int wc, int fr, int fq) const {
        const int row0 = u.pm * BM + wr * 64 + fr, col0 = u.pn * BM + wc * 32 + 8 * fq;
#pragma unroll
        for (int ai = 0; ai < 2; ++ai) {
            u32x4 ga[4][2], gb[4][2];
#pragma unroll
            for (int m = 0; m < 4; ++m)
#pragma unroll
                for (int bj = 0; bj < 2; ++bj) { const bf16_t* gp = gate + (size_t)(row0 + ai * HALF + m * 16) * ldg + col0 + bj * HALF + seg * 2048; ga[m][bj] = __builtin_nontemporal_load((const u32x4*)gp); gb[m][bj] = __builtin_nontemporal_load((const u32x4*)(gp + 2048)); }
#pragma unroll
            for (int m = 0; m < 4; ++m)
#pragma unroll
                for (int bj = 0; bj < 2; ++bj) { const u32x4 a = ga[m][bj], b = gb[m][bj];
                    f32x4& v0 = acc[ai][bj][m][0]; f32x4& v1 = acc[ai][bj][m][1];
                    v0[0] *= ratio(bflo(a.x), bflo(b.x)); v0[1] *= ratio(bfhi(a.x), bfhi(b.x)); v0[2] *= ratio(bflo(a.y), bflo(b.y)); v0[3] *= ratio(bfhi(a.y), bfhi(b.y));
                    v1[0] *= ratio(bflo(a.z), bflo(b.z)); v1[1] *= ratio(bfhi(a.z), bfhi(b.z)); v1[2] *= ratio(bflo(a.w), bflo(b.w)); v1[3] *= ratio(bfhi(a.w), bfhi(b.w)); }
            asm volatile("" ::: "memory"); }
    }
    __device__ __forceinline__ void operator()(const f32x4 (&acc)[2][2][4][2], const Unit& u, int wr, int wc, int fr, int fq) const {
        const int row0 = u.pm * BM + wr * 64 + fr, col0 = u.pn * BM + wc * 32 + 8 * fq;
#pragma unroll
        for (int ai = 0; ai < 2; ++ai) {
            u32x4 gc[4][2];
#pragma unroll
            for (int m = 0; m < 4; ++m)
#pragma unroll
                for (int bj = 0; bj < 2; ++bj) gc[m][bj] = __builtin_nontemporal_load((const u32x4*)(gate + (size_t)(row0 + ai * HALF + m * 16) * ldg + col0 + bj * HALF + 4096));
#pragma unroll
            for (int m = 0; m < 4; ++m) { const size_t row = (size_t)(row0 + ai * HALF + m * 16);
#pragma unroll
                for (int bj = 0; bj < 2; ++bj) { const u32x4 g = gc[m][bj];
                    f32x4 v0 = acc[ai][bj][m][0], v1 = acc[ai][bj][m][1];
                    v0[0] *= sigmoidf_(bflo(g.x)); v0[1] *= sigmoidf_(bfhi(g.x)); v0[2] *= sigmoidf_(bflo(g.y)); v0[3] *= sigmoidf_(bfhi(g.y));
                    v1[0] *= sigmoidf_(bflo(g.z)); v1[1] *= sigmoidf_(bfhi(g.z)); v1[2] *= sigmoidf_(bflo(g.w)); v1[3] *= sigmoidf_(bfhi(g.w));
                    u32x4 w; w.x = pk2(v0[0], v0[1]); w.y = pk2(v0[2], v0[3]); w.z = pk2(v1[0], v1[1]); w.w = pk2(v1[2], v1[3]);
                    *(u32x4*)(mout + row * DM + col0 + bj * HALF) = w; } }
            asm volatile("" ::: "memory"); }
    }
};
struct EpiConvAct {
    static constexpr bool PERM = true; static constexpr int MIDK = 0; static constexpr bool AROWPERM = true; static constexpr bool BJADJ = false;
    bf16_t* act; const float* cw; const float* cb; float* edge;
    __device__ __forceinline__ void operator()(const f32x4 (&acc)[2][2][4][2], const Unit& u, int wr, int wc, int fr, int fq) const {
        const int col0 = u.pn * 128 + wc * 32 + 8 * fq;
        const int tok0 = u.pm * BM + 128 * wr + 8 * fr;
        float w0[8], w1[8], w2[8], bs[8];
        { const f32x4 x0 = *(const f32x4*)(cw + col0), x1 = *(const f32x4*)(cw + col0 + 4), y0 = *(const f32x4*)(cw + FFN + col0), y1 = *(const f32x4*)(cw + FFN + col0 + 4);
          const f32x4 z0 = *(const f32x4*)(cw + 2 * FFN + col0), z1 = *(const f32x4*)(cw + 2 * FFN + col0 + 4), b0 = *(const f32x4*)(cb + col0), b1 = *(const f32x4*)(cb + col0 + 4);
#pragma unroll
          for (int j = 0; j < 4; ++j) { w0[j] = x0[j]; w0[4 + j] = x1[j]; w1[j] = y0[j]; w1[4 + j] = y1[j]; w2[j] = z0[j]; w2[4 + j] = z1[j]; bs[j] = b0[j]; bs[4 + j] = b1[j]; } }
        float gprev0[8], gnext7[8];
#pragma unroll
        for (int n = 0; n < 2; ++n)
#pragma unroll
            for (int j = 0; j < 4; ++j) { gprev0[4 * n + j] = dpp_f<0x111>(acc[1][1][3][n][j]); gnext7[4 * n + j] = dpp_f<0x101>(acc[0][1][0][n][j]); }
#pragma unroll
        for (int idx = 0; idx < 8; ++idx) { const int ai = idx >> 2, m = idx & 3;
            float y[8], o[8];
#pragma unroll
            for (int n = 0; n < 2; ++n)
#pragma unroll
                for (int j = 0; j < 4; ++j) { const int e = 4 * n + j;
                    const float gp = idx > 0 ? acc[(idx - 1) >> 2][1][(idx - 1) & 3][n][j] : gprev0[e];
                    const float gn = idx < 7 ? acc[(idx + 1) >> 2][1][(idx + 1) & 3][n][j] : gnext7[e];
                    y[e] = w0[e] * gp + w1[e] * acc[ai][1][m][n][j] + w2[e] * gn + bs[e];
                    o[e] = y[e] * sigmoidf_(y[e]) * acc[ai][0][m][n][j]; }
            *(u32x4*)(act + (size_t)(tok0 + idx) * FFN + col0) = pack8f(o);
            if ((idx == 0 && fr == 0) || (idx == 7 && fr == 15)) {
                float* e = edge + ((size_t)((u.pm * 2 + wr) * 2 + (idx == 7 ? 1 : 0)) * 3) * FFN + col0;
                *(f32x4*)e = (f32x4){y[0], y[1], y[2], y[3]}; *(f32x4*)(e + 4) = (f32x4){y[4], y[5], y[6], y[7]};
                *(f32x4*)(e + FFN) = acc[ai][0][m][0]; *(f32x4*)(e + FFN + 4) = acc[ai][0][m][1];
                *(f32x4*)(e + 2 * FFN) = acc[ai][1][m][0]; *(f32x4*)(e + 2 * FFN + 4) = acc[ai][1][m][1]; }
        }
    }
};
struct EpiResid {
    static constexpr bool PERM = true; static constexpr int MIDK = 0; static constexpr bool AROWPERM = false; static constexpr bool BJADJ = false;
    const float* xc; const float* xl;
    bf16_t* xb; float* out; const float* gmod;
    int in_f32, out_f32;
    __device__ __forceinline__ void operator()(const f32x4 (&acc)[2][2][4][2], const Unit& u, int wr, int wc, int fr, int fq) const {
        const int row0 = u.pm * BM + wr * 64 + fr, col0 = u.pn * BM + wc * 32 + 8 * fq;
        const int grp = u.pm < 32 ? 0 : 1 + ((u.pm - 32) >> 4);
        const float* gv = gmod + (size_t)grp * (6 * DM);
#define RESID_GATES() f32x4 gg[2][2]; _Pragma("unroll") for (int bj = 0; bj < 2; ++bj) { gg[bj][0] = *(const f32x4*)(gv + col0 + bj * HALF); gg[bj][1] = *(const f32x4*)(gv + col0 + bj * HALF + 4); }
#define RESID_OUT(Y0, Y1, RO) do { if (out_f32) { *(f32x4*)(out + (RO)) = (Y0); *(f32x4*)(out + (RO) + 4) = (Y1); } \
        else { u32x4 w_; w_.x = pk2((Y0)[0], (Y0)[1]); w_.y = pk2((Y0)[2], (Y0)[3]); w_.z = pk2((Y1)[0], (Y1)[1]); w_.w = pk2((Y1)[2], (Y1)[3]); *(u32x4*)(xb + (RO)) = w_; } } while (0)
        if (in_f32) {
#pragma unroll
            for (int ai = 0; ai < 2; ++ai)
#pragma unroll
                for (int mh = 0; mh < 2; ++mh) {
                    RESID_GATES();
                    f32x4 xo[2][2][2];
#pragma unroll
                    for (int mm = 0; mm < 2; ++mm) { const int row = row0 + ai * HALF + (2 * mh + mm) * 16;
                        const float* xr = (row < NTC) ? xc + (size_t)row * DM : xl + (size_t)(row - NTC) * DM;
#pragma unroll
                        for (int bj = 0; bj < 2; ++bj) { xo[mm][bj][0] = *(const f32x4*)(xr + col0 + bj * HALF); xo[mm][bj][1] = *(const f32x4*)(xr + col0 + bj * HALF + 4); } }
#pragma unroll
                    for (int mm = 0; mm < 2; ++mm) { const int m = 2 * mh + mm; const size_t ro = (size_t)(row0 + ai * HALF + m * 16) * DM + col0;
#pragma unroll
                        for (int bj = 0; bj < 2; ++bj) { const f32x4 y0 = xo[mm][bj][0] + gg[bj][0] * acc[ai][bj][m][0], y1 = xo[mm][bj][1] + gg[bj][1] * acc[ai][bj][m][1]; RESID_OUT(y0, y1, ro + bj * HALF); } }
                    asm volatile("" ::: "memory"); }
        } else {
#pragma unroll
            for (int ai = 0; ai < 2; ++ai) {
                RESID_GATES();
                u32x4 xw[4][2];
#pragma unroll
                for (int m = 0; m < 4; ++m)
#pragma unroll
                    for (int bj = 0; bj < 2; ++bj) xw[m][bj] = *(const u32x4*)(xb + (size_t)(row0 + ai * HALF + m * 16) * DM + col0 + bj * HALF);
#pragma unroll
                for (int m = 0; m < 4; ++m) { const size_t ro = (size_t)(row0 + ai * HALF + m * 16) * DM + col0;
#pragma unroll
                    for (int bj = 0; bj < 2; ++bj) { const u32x4 w = xw[m][bj];
                        const f32x4 y0 = (f32x4){bflo(w.x), bfhi(w.x), bflo(w.y), bfhi(w.y)} + gg[bj][0] * acc[ai][bj][m][0], y1 = (f32x4){bflo(w.z), bfhi(w.z), bflo(w.w), bfhi(w.w)} + gg[bj][1] * acc[ai][bj][m][1];
                        RESID_OUT(y0, y1, ro + bj * HALF); } }
                asm volatile("" ::: "memory"); }
        }
#undef RESID_OUT
#undef RESID_GATES
    }
};

template <class Epi, class Sched>
__device__ __forceinline__ void gemm_phase(LAS unsigned char* lds, const Gemm g, const Sched& S, const Epi& E) {
    int tid_ = threadIdx.x; asm volatile("" : "+v"(tid_));
    const int tid = tid_, wid = __builtin_amdgcn_readfirstlane(tid >> 6), lane = tid & 63, wr = wid >> 2, wc = wid & 3, fr = lane & 15, fq = lane >> 4;
    const int K = g.K, nt = K / BK, lda = g.lda;
    unsigned voffA[2], voffB[2];
#pragma unroll
    for (int i = 0; i < 2; ++i) { int R, C; stage_rc(tid * 16 + i * 8192, R, C); const int Rb = Epi::BJADJ ? (2 * (R & ~31) + perm32(R & 31)) : Epi::PERM ? ((R & ~31) + perm32(R & 31)) : R;
        const int Ra = Epi::AROWPERM ? (128 * ((R >> 6) & 1) + 8 * (R & 15) + ((R >> 4) & 3)) : R;
        voffA[i] = (unsigned)(Ra * lda + C) * 2u; voffB[i] = (unsigned)(Rb * K + C) * 2u; }
    const size_t kstep = (size_t)(BK * 2);
    const size_t hstepA = (size_t)(Epi::AROWPERM ? 4 : HALF) * lda * 2, hstepB = (size_t)(Epi::BJADJ ? 32 : HALF) * K * 2;
    const size_t tstepA = (size_t)BM * lda * 2, tstepB = (size_t)BM * K * 2;
    const unsigned ldsw = (unsigned)wid * 1024u;
    const int aoff = lds_byte(wr * 64 + fr, fq * 8), boff = lds_byte(wc * 32 + fr, fq * 8);
#define PG8_SA(b, h) (((b) * 2 + (h)) * HTB)
#define PG8_SB(b, h) ((4 + (b) * 2 + (h)) * HTB)
#define PG8_STAGE(bufoff, gbase, voff) do { _Pragma("unroll") for (int _i = 0; _i < 2; ++_i) \
        __builtin_amdgcn_global_load_lds((const unsigned*)((const char*)(gbase) + (voff)[_i]), (LAS unsigned*)(lds + (bufoff) + ldsw + _i * 8192), 16, 0, 0); } while (0)
#define PG8_LDA(dst, b, h) do { _Pragma("unroll") for (int m = 0; m < 4; ++m) _Pragma("unroll") for (int k = 0; k < 2; ++k) dst[m][k] = *(const LAS bf16x8*)(lds + PG8_SA(b, h) + aoff + m * 2048 + k * 1024); } while (0)
#define PG8_LDB(dst, b, h) do { _Pragma("unroll") for (int n = 0; n < 2; ++n) _Pragma("unroll") for (int k = 0; k < 2; ++k) dst[n][k] = *(const LAS bf16x8*)(lds + PG8_SB(b, h) + boff + n * 2048 + k * 1024); } while (0)
#define PG8_MMA(ai, bj, At, Bt) do { __builtin_amdgcn_s_setprio(1); _Pragma("unroll") for (int m = 0; m < 4; ++m) _Pragma("unroll") for (int n = 0; n < 2; ++n) _Pragma("unroll") for (int k = 0; k < 2; ++k) \
        acc[ai][bj][m][n] = __builtin_amdgcn_mfma_f32_16x16x32_bf16(Bt[n][k], At[m][k], acc[ai][bj][m][n], 0, 0, 0); __builtin_amdgcn_s_setprio(0); } while (0)
#define PG8_WAIT_V(n) asm volatile("s_waitcnt vmcnt(" #n ")" ::: "memory")
#define PG8_WAIT_L(n) asm volatile("s_waitcnt lgkmcnt(" #n ")" ::: "memory")
#define PG8_BAR __builtin_amdgcn_s_barrier()
#define PG8_SCHED __builtin_amdgcn_sched_barrier(0)
    Unit cur, nxt; int ui = 0;
    if (!S.next(0, cur)) return;
    f32x4 acc[2][2][4][2];
#pragma unroll
    for (int a = 0; a < 2; ++a)
#pragma unroll
        for (int b = 0; b < 2; ++b)
#pragma unroll
            for (int m = 0; m < 4; ++m)
#pragma unroll
                for (int n = 0; n < 2; ++n) acc[a][b][m][n] = (f32x4){0.f, 0.f, 0.f, 0.f};
    bf16x8 At[4][2], B0[2][2], B1[2][2];
    const char* cA = (const char*)g.A + (size_t)cur.pm * tstepA; const char* cB = (const char*)g.Bt + (size_t)cur.pn * tstepB;
    S.a_ready(cur);
    PG8_STAGE(PG8_SB(0, 0), cB, voffB); PG8_STAGE(PG8_SA(0, 0), cA, voffA); PG8_STAGE(PG8_SB(0, 1), cB + hstepB, voffB); PG8_STAGE(PG8_SA(0, 1), cA + hstepA, voffA);
    if (wr == 1) PG8_BAR;
    PG8_WAIT_V(4); PG8_BAR;
    PG8_STAGE(PG8_SB(1, 0), cB + kstep, voffB); PG8_STAGE(PG8_SA(1, 0), cA + kstep, voffA); PG8_STAGE(PG8_SB(1, 1), cB + hstepB + kstep, voffB);
    PG8_WAIT_V(6); PG8_BAR;
    for (;;) {
        const bool has_next = S.next(ui + 1, nxt);
        const char* nA = has_next ? (const char*)g.A + (size_t)nxt.pm * tstepA : cA; const char* nB = has_next ? (const char*)g.Bt + (size_t)nxt.pn * tstepB : cB;
        for (int t = 0; t < nt; t += 2) {
            const bool last = (t == nt - 2);
            const char* a1 = cA + (size_t)(t + 1) * kstep;
            const char* a2 = last ? nA : cA + (size_t)(t + 2) * kstep; const char* b2 = last ? nB : cB + (size_t)(t + 2) * kstep;
            const char* a3 = a2 + kstep; const char* b3 = b2 + kstep;
            if (last && has_next) S.a_ready(nxt);
            if constexpr (Epi::MIDK > 0) { if (t > 0 && (t % Epi::MIDK) == 0) E.mid(acc, cur, t / Epi::MIDK - 1, wr, wc, fr, fq); }
            PG8_LDB(B0, 0, 0); PG8_SCHED; PG8_LDA(At, 0, 0); PG8_STAGE(PG8_SA(1, 1), a1 + hstepA, voffA);
            PG8_WAIT_L(8); PG8_BAR; PG8_WAIT_L(0); PG8_MMA(0, 0, At, B0); PG8_BAR; PG8_SCHED;
            PG8_LDB(B1, 0, 1); PG8_STAGE(PG8_SB(0, 0), b2, voffB);
            PG8_BAR; PG8_WAIT_L(0); PG8_MMA(0, 1, At, B1); PG8_BAR;
            PG8_LDA(At, 0, 1); PG8_STAGE(PG8_SA(0, 0), a2, voffA);
            PG8_BAR; PG8_WAIT_L(0); PG8_MMA(1, 0, At, B0); PG8_BAR; PG8_SCHED;
            PG8_STAGE(PG8_SB(0, 1), b2 + hstepB, voffB);
            PG8_WAIT_V(6); PG8_BAR; PG8_MMA(1, 1, At, B1); PG8_BAR;
            PG8_LDB(B0, 1, 0); PG8_SCHED; PG8_LDA(At, 1, 0); PG8_STAGE(PG8_SA(0, 1), a2 + hstepA, voffA);
            PG8_WAIT_L(8); PG8_BAR; PG8_WAIT_L(0); PG8_MMA(0, 0, At, B0); PG8_BAR; PG8_SCHED;
            PG8_LDB(B1, 1, 1); PG8_STAGE(PG8_SB(1, 0), b3, voffB);
            PG8_BAR; PG8_WAIT_L(0); PG8_MMA(0, 1, At, B1); PG8_BAR;
            PG8_LDA(At, 1, 1); PG8_STAGE(PG8_SA(1, 0), a3, voffA);
            PG8_BAR; PG8_WAIT_L(0); PG8_MMA(1, 0, At, B0); PG8_BAR; PG8_SCHED;
            PG8_STAGE(PG8_SB(1, 1), b3 + hstepB, voffB);
            PG8_WAIT_V(6); PG8_BAR; PG8_MMA(1, 1, At, B1); PG8_BAR;
        }
        E(acc, cur, wr, wc, fr, fq); S.done(cur);
        if (!has_next) break;
#pragma unroll
        for (int a = 0; a < 2; ++a)
#pragma unroll
            for (int b = 0; b < 2; ++b)
#pragma unroll
                for (int m = 0; m < 4; ++m)
#pragma unroll
                    for (int n = 0; n < 2; ++n) acc[a][b][m][n] = (f32x4){0.f, 0.f, 0.f, 0.f};
        cur = nxt; cA = nA; cB = nB; ++ui;
    }
    PG8_WAIT_V(0);
    if (wr == 0) PG8_BAR;
    PG8_BAR;
#undef PG8_SA
#undef PG8_SB
#undef PG8_STAGE
#undef PG8_LDA
#undef PG8_LDB
#undef PG8_MMA
#undef PG8_WAIT_V
#undef PG8_WAIT_L
#undef PG8_BAR
#undef PG8_SCHED
}
}
typedef __attribute__((address_space(1))) float gf32_t;
typedef __attribute__((address_space(1))) unsigned char gu8_t;
struct ParamsH {
    const float* in[30];
    float* out;
    unsigned char* ws;
    int ph_lo, ph_hi;
};
struct Params {
    const gf32_t* in[30];
    gf32_t* out;
    gu8_t* ws;
    int ph_lo, ph_hi;
};
static_assert(sizeof(ParamsH) == sizeof(Params), "layout");
enum { I_XP = 0, I_XS, I_CCKV, I_CKPE, I_CNAK, I_CNAV, I_SHG, I_C, I_CCTX, I_WMOD, I_BMOD, I_N1G, I_N2G, I_WIN, I_KVG, I_QG, I_KG, I_WUK, I_WUV,
       I_LB, I_HGG, I_NAQG, I_NAKG, I_RPB, I_WBR, I_WOUT, I_WUP, I_CONVW, I_CONVB, I_WDN };
constexpr size_t O_YP = 0, O_YS = (size_t)NTC * DM, O_CKV = (size_t)NTOK * DM, O_KPE = O_CKV + (size_t)32 * 4 * 256 * 512,
                 O_NAK = O_KPE + (size_t)32 * 4 * 256 * 64, O_NAV = O_NAK + (size_t)32 * 4 * 256 * 1024, O_HGS = O_NAV + (size_t)32 * 4 * 256 * 1024,
                 O_END = O_HGS + (size_t)32 * 4 * 2 * 8 * 128 * 128;

struct Ctx {
    LAS unsigned char* lds; int tid, lane, wid, G, bid;
};
typedef const __attribute__((address_space(4))) Params* PkPtr;
DI PkPtr lp(PkPtr q) { asm volatile("" : "+s"(q)); return q; }
DI Ctx launder(const Ctx& c0) { Ctx c = c0; int t = c0.tid; asm volatile("" : "+v"(t)); c.tid = t; c.lane = t & 63; return c; }

constexpr int TRI_PER_LAYER = 256 * 8 + 8 + 2 * 16 * 2 + 3 * 32 * 4 + 32 * 8 + 176 * 8 + 32 * 22;
constexpr int TRI_EARLY = 256 * 8 + 8 + 2 * 16 * 2;
struct TrItem { const float* src; bf16_t* dst; int ldsrc, K; int zero; };
DI void tr_item(PkPtr p, int t, TrItem& it) {
    it.zero = 0;
    const int l = t / TRI_PER_LAYER; int r = t % TRI_PER_LAYER;
    bf16_t* wl = (bf16_t*)(((unsigned char*)p->ws) + WS_WT + (size_t)(l & 1) * WL_BYTES);
    if (r < 256 * 8) { const int nt = r / 8, kt = r % 8, n0 = nt * 64; const int sc = n0 < 2048 ? n0 : n0 + 64;
        it.src = ((const float*)p->in[I_WIN]) + (size_t)l * DM * NIN_SRC + (size_t)(kt * 256) * NIN_SRC + sc; it.ldsrc = NIN_SRC; it.K = DM; it.dst = wl + WL_IN / 2 + (size_t)n0 * DM + kt * 256; return; }
    r -= 256 * 8;
    if (r < 8) { const int kt = r;
        it.src = ((const float*)p->in[I_WIN]) + (size_t)l * DM * NIN_SRC + (size_t)(kt * 256) * NIN_SRC + 2048; it.ldsrc = NIN_SRC; it.K = DM; it.dst = wl + WL_KPE / 2 + kt * 256; return; }
    r -= 8;
    if (r < 64) { const int which = r / 32, q = r % 32, nt = q / 2, kt = q % 2;
        it.src = ((const float*)p->in[which ? I_WUV : I_WUK]) + (size_t)l * 512 * 1024 + (size_t)(kt * 256) * 1024 + nt * 64; it.ldsrc = 1024; it.K = 512; it.dst = wl + WL_KV / 2 + (size_t)(which * 1024 + nt * 64) * 512 + kt * 256; return; }
    r -= 64;
    if (r < 384) { const int i = r / 128, q = r % 128, nt = q / 4, kt = q % 4;
        it.src = ((const float*)p->in[I_WBR]) + ((size_t)l * 3 + i) * 1024 * DM + (size_t)(kt * 256) * DM + nt * 64; it.ldsrc = DM; it.K = 3072; it.dst = wl + WL_BR / 2 + (size_t)(nt * 64) * 3072 + i * 1024 + kt * 256; return; }
    r -= 384;
    if (r < 256) { const int nt = r / 8, kt = r % 8;
        it.src = ((const float*)p->in[I_WOUT]) + (size_t)l * DM * DM + (size_t)(kt * 256) * DM + nt * 64; it.ldsrc = DM; it.K = DM; it.dst = wl + WL_OUT / 2 + (size_t)(nt * 64) * DM + kt * 256; return; }
    r -= 256;
    if (r < 176 * 8) { const int nt = r / 8, kt = r % 8;
        const int half = nt / 88, np = (nt % 88) * 64, drow = 256 * (np / 128) + 128 * half + (np % 128);
        it.src = ((const float*)p->in[I_WUP]) + (size_t)l * DM * FFN2 + (size_t)(kt * 256) * FFN2 + nt * 64; it.ldsrc = FFN2; it.K = DM; it.dst = wl + WL_UP / 2 + (size_t)drow * DM + kt * 256; return; }
    r -= 176 * 8;
    { const int nt = r / 22, kt = r % 22;
        it.src = ((const float*)p->in[I_WDN]) + (size_t)l * FFN * DM + (size_t)(kt * 256) * DM + nt * 64; it.ldsrc = DM; it.K = FFN; it.dst = wl + WL_DN / 2 + (size_t)(nt * 64) * FFN + kt * 256; return; }
}
DI void prologue_transposes(const Ctx& c0, PkPtr p, int t0, int tstep, int t_end) {
    const Ctx c = launder(c0);
    LAS float* T = (LAS float*)c.lds;
    const int tid = c.tid, i = tid >> 4, j = (tid & 15) * 4, nn = tid >> 3, k8 = (tid & 7) * 8;
    f32x4 v[8];
    int t = t0;
    if (t >= t_end) return;
    TrItem cur; tr_item(p, t, cur);
    if (!cur.zero) {
#pragma unroll
        for (int q = 0; q < 8; ++q) v[q] = *(const f32x4*)(cur.src + (size_t)(i + 32 * q) * cur.ldsrc + j);
    }
    for (;;) {
        if (!cur.zero) {
#pragma unroll
            for (int q = 0; q < 8; ++q) { T[(j + 0) * 257 + i + 32 * q] = v[q][0]; T[(j + 1) * 257 + i + 32 * q] = v[q][1]; T[(j + 2) * 257 + i + 32 * q] = v[q][2]; T[(j + 3) * 257 + i + 32 * q] = v[q][3]; }
        }
        __syncthreads();
        const int tn = t + tstep; const bool more = tn < t_end;
        bf16_t* const cdst = cur.dst; const int cK = cur.K, czero = cur.zero;
        if (more) { tr_item(p, tn, cur);
            if (!cur.zero) {
#pragma unroll
                for (int q = 0; q < 8; ++q) v[q] = *(const f32x4*)(cur.src + (size_t)(i + 32 * q) * cur.ldsrc + j);
            } }
#pragma unroll
        for (int q = 0; q < 4; ++q) { u32x4 w = {0u, 0u, 0u, 0u};
            if (!czero) { const LAS float* r = T + nn * 257 + k8 + 64 * q; w.x = pk2(r[0], r[1]); w.y = pk2(r[2], r[3]); w.z = pk2(r[4], r[5]); w.w = pk2(r[6], r[7]); }
            *(u32x4*)(cdst + (size_t)nn * cK + k8 + 64 * q) = w; }
        __syncthreads();
        if (!more) break;
        t = tn;
    }
}

DI void prologue_modulation(const Ctx& c0, PkPtr p) {
    const Ctx c = launder(c0);
    LAS float* SC = (LAS float*)c.lds;
    LAS float* RED = SC + 5 * DM;
    for (int i = c.tid; i < 5 * DM; i += 512) { const int g = i / DM, k = i % DM; const float x = g == 0 ? ((const float*)p->in[I_CCTX])[k] : ((const float*)p->in[I_C])[(g - 1) * DM + k]; SC[i] = x * sigmoidf_(x); }
    __syncthreads();
    float* MOD = (float*)(((unsigned char*)p->ws) + WS_MOD);
    const int c4 = (c.tid & 15) * 4, ks = c.tid >> 4;
    for (int u = c.bid; u < DEPTH * 192; u += c.G) {
        const int l = u / 192, n0 = (u % 192) * 64;
        const float* w = ((const float*)p->in[I_WMOD]) + (size_t)l * DM * (6 * DM) + n0 + c4;
        f32x4 a0 = {0.f, 0.f, 0.f, 0.f}, a1 = a0, a2 = a0, a3 = a0, a4 = a0;
#pragma unroll 8
        for (int k = ks * 64; k < ks * 64 + 64; ++k) { const f32x4 wv = *(const f32x4*)(w + (size_t)k * (6 * DM));
            a0 += wv * SC[k]; a1 += wv * SC[DM + k]; a2 += wv * SC[2 * DM + k]; a3 += wv * SC[3 * DM + k]; a4 += wv * SC[4 * DM + k]; }
        *(LAS f32x4*)(RED + (ks * 5 + 0) * 64 + c4) = a0; *(LAS f32x4*)(RED + (ks * 5 + 1) * 64 + c4) = a1; *(LAS f32x4*)(RED + (ks * 5 + 2) * 64 + c4) = a2;
        *(LAS f32x4*)(RED + (ks * 5 + 3) * 64 + c4) = a3; *(LAS f32x4*)(RED + (ks * 5 + 4) * 64 + c4) = a4;
        __syncthreads();
        if (c.tid < 320) { const int g = c.tid >> 6, col = c.tid & 63; float s = ((const float*)p->in[I_BMOD])[(size_t)l * (6 * DM) + n0 + col];
#pragma unroll
            for (int q = 0; q < 32; ++q) s += RED[(q * 5 + g) * 64 + col];
            MOD[((size_t)l * 5 + g) * (6 * DM) + n0 + col] = s; }
        __syncthreads();
    }
}

DI void prologue_misc(const Ctx& c0, PkPtr p) {
    const Ctx c = launder(c0);
    float* LOW = (float*)(((unsigned char*)p->ws) + WS_LOWER);
    const int gt = c.bid * 512 + c.tid, GT = c.G * 512;
    for (int i = gt; i < 2 * 1024; i += GT) { const int d = i >> 10, ch = i & 1023; const float* s = ((const float*)p->in[I_LB]) + (size_t)d * 4 * 1024 + ch;
        const float x0 = s[0], x1 = s[1024], x2 = s[2048], x3 = s[3072]; const float mx = fmaxf(fmaxf(x0, x1), fmaxf(x2, x3));
        const float e0 = expf(x0 - mx), e1 = expf(x1 - mx), e2 = expf(x2 - mx), e3 = expf(x3 - mx); const float inv = 1.0f / (e0 + e1 + e2 + e3);
        float* o = LOW + (size_t)d * 4 * 1024 + ch; o[0] = 0.f; o[1024] = e1 * inv; o[2048] = (e1 + e2) * inv; o[3072] = (e1 + e2 + e3) * inv; }
    float* RT = (float*)(((unsigned char*)p->ws) + WS_ROPE);
    for (int i = gt; i < 1024; i += GT) { const int pos = i >> 4, f = i & 15; const float inv = powf(10000.0f, -(float)f / 16.0f); const float a = (float)pos * inv;
        RT[i] = cosf(a); RT[1024 + i] = sinf(a); }
    bf16_t* kc = (bf16_t*)(((unsigned char*)p->ws) + WS_NAKC); bf16_t* vc = (bf16_t*)(((unsigned char*)p->ws) + WS_NAVC);
    const size_t n8 = (size_t)4 * 4 * 512 * 1024 / 8;
    for (size_t i = gt; i < 2 * n8; i += GT) { const bool isv = i >= n8; const size_t j = isv ? i - n8 : i; const size_t e = j * 8;
        const size_t b = e / ((size_t)4 * 512 * 1024), rem = e % ((size_t)4 * 512 * 1024), l = rem / ((size_t)512 * 1024), r2 = rem % ((size_t)512 * 1024);
        const float* s = ((const float*)p->in[isv ? I_CNAV : I_CNAK]) + e; const f32x4 a = *(const f32x4*)s, bq = *(const f32x4*)(s + 4);
        u32x4 w; w.x = pk2(a[0], a[1]); w.y = pk2(a[2], a[3]); w.z = pk2(bq[0], bq[1]); w.w = pk2(bq[2], bq[3]);
        *(u32x4*)((isv ? vc : kc) + (l * 4 + b) * ((size_t)512 * 1024) + r2) = w; }
}

DI int row_group(int row) { return row < NTC ? 0 : 1 + ((row - NTC) >> 12); }

DI void phase_norm(const Ctx& c0, PkPtr p, int l, bool first, const float* gain, int ish, int isc) {
    const Ctx c = launder(c0);
    const float* MOD = (const float*)(((unsigned char*)p->ws) + WS_MOD) + (size_t)l * 5 * 6 * DM;
    bf16_t* H = (bf16_t*)(((unsigned char*)p->ws) + WS_H); const bf16_t* XB = (const bf16_t*)(((unsigned char*)p->ws) + WS_XB);
    const int nw = c.G * 8, per = (NTOK + nw - 1) / nw, r0 = (c.bid * 8 + c.wid) * per, r1 = r0 + per < NTOK ? r0 + per : NTOK;
    if (r0 >= r1) return;
    float v[4][8], av[4][8], sv[4][8]; f32x4 nf[4][2]; u32x4 nb[4]; int cur = -1;
#define NORM_LOAD(row) do { if (first) { const float* x_ = (row) < NTC ? ((const float*)p->in[I_XP]) + (size_t)(row) * DM : ((const float*)p->in[I_XS]) + (size_t)((row) - NTC) * DM; \
        _Pragma("unroll") for (int i = 0; i < 4; ++i) { nf[i][0] = *(const f32x4*)(x_ + i * 512 + c.lane * 8); nf[i][1] = *(const f32x4*)(x_ + i * 512 + c.lane * 8 + 4); } } \
    else { _Pragma("unroll") for (int i = 0; i < 4; ++i) nb[i] = *(const u32x4*)(XB + (size_t)(row) * DM + i * 512 + c.lane * 8); } } while (0)
    NORM_LOAD(r0);
    for (int row = r0; row < r1; ++row) {
        if (first) {
#pragma unroll
            for (int i = 0; i < 4; ++i)
#pragma unroll
                for (int j = 0; j < 4; ++j) { v[i][j] = nf[i][0][j]; v[i][4 + j] = nf[i][1][j]; }
        } else {
#pragma unroll
            for (int i = 0; i < 4; ++i) unpack8(nb[i], v[i]);
        }
        if (row + 1 < r1) NORM_LOAD(row + 1);
        const int grp = row_group(row);
        if (grp != cur) { cur = grp; const float* mg = MOD + (size_t)grp * 6 * DM;
#pragma unroll
            for (int i = 0; i < 4; ++i)
#pragma unroll
                for (int h2 = 0; h2 < 2; ++h2) { const int col = i * 512 + c.lane * 8 + 4 * h2;
                    const f32x4 a = *(const f32x4*)(gain + col) * (*(const f32x4*)(mg + isc * DM + col) + 1.0f), sft = *(const f32x4*)(mg + ish * DM + col);
#pragma unroll
                    for (int j = 0; j < 4; ++j) { av[i][4 * h2 + j] = a[j]; sv[i][4 * h2 + j] = sft[j]; } } }
        float ss = 0.f;
#pragma unroll
        for (int i = 0; i < 4; ++i)
#pragma unroll
            for (int j = 0; j < 8; ++j) ss += v[i][j] * v[i][j];
        ss = wave_sum(ss, c.lane);
        const float rinv = rsqrtf(ss * (1.0f / DM) + EPS);
#pragma unroll
        for (int i = 0; i < 4; ++i) { float y[8];
#pragma unroll
            for (int j = 0; j < 8; ++j) y[j] = v[i][j] * rinv * av[i][j] + sv[i][j];
            *(u32x4*)(H + (size_t)row * DM + i * 512 + c.lane * 8) = pack8f(y); }
    }
#undef NORM_LOAD
}

DI void phase_kpe(const Ctx& c0, PkPtr p, int l) {
    const Ctx c = launder(c0);
    const int lane = c.lane, r = lane & 31, hh = lane >> 5, ch = (c.bid >> 3) & 1, pairi = (c.bid & 7) + 8 * (c.bid >> 4);
    const bf16_t* Bg = (const bf16_t*)(((unsigned char*)p->ws) + WS_WT + (size_t)(l & 1) * WL_BYTES + WL_KPE) + (size_t)(ch * 32) * DM;
#pragma unroll
    for (int i = 0; i < 16; ++i) { const int sl = c.tid + 512 * i, row = sl >> 8, cchunk = (sl & 255) ^ (row & 15);
        __builtin_amdgcn_global_load_lds((const unsigned*)(Bg + (size_t)row * DM + cchunk * 8), (LAS unsigned*)(c.lds + (unsigned)(c.wid * 64 + 512 * i) * 16u), 16, 0, 0); }
    const int rbk = pairi * 6 + c.wid;
    const bool act = c.wid < 6 && rbk < NTOK / 32;
    const bf16_t* A = (const bf16_t*)(((unsigned char*)p->ws) + WS_H) + (size_t)((act ? rbk : 0) * 32 + r) * DM + 8 * hh;
    bf16x8 a[32];
    if (act) {
#pragma unroll
        for (int q = 0; q < 32; ++q) a[q] = *(const bf16x8*)(A + 16 * q);
    }
    asm volatile("s_waitcnt vmcnt(0)" ::: "memory"); __syncthreads();
    if (act) {
        f32x16 acc = f32x16{};
        const LAS char* brow = (const LAS char*)(c.lds + r * 4096);
        for (int k0 = 0; k0 < DM; k0 += 512) {
            bf16x8 an[32];
            if (k0 + 512 < DM) {
#pragma unroll
                for (int q = 0; q < 32; ++q) an[q] = *(const bf16x8*)(A + k0 + 512 + 16 * q);
            }
#pragma unroll
            for (int q = 0; q < 32; ++q) { const int chunk = (k0 >> 3) + 2 * q + hh;
                const bf16x8 bq = *(const LAS bf16x8*)(brow + ((chunk ^ (r & 15)) << 4));
                acc = __builtin_amdgcn_mfma_f32_32x32x16_bf16(a[q], bq, acc, 0, 0, 0); }
            if (k0 + 512 < DM) {
#pragma unroll
                for (int q = 0; q < 32; ++q) a[q] = an[q];
            }
        }
        bf16_t* O = (bf16_t*)(((unsigned char*)p->ws) + WS_KPE) + (size_t)(rbk * 32) * 64 + ch * 32;
#pragma unroll
        for (int i = 0; i < 16; ++i) { const int row = (i & 3) + 8 * (i >> 2) + 4 * hh; O[(size_t)row * 64 + r] = f2bf(acc[i]); }
    }
    __syncthreads();
}

DI void phase_prep_tokens(const Ctx& c0, PkPtr p, int l) {
    const Ctx c = launder(c0);
    bf16_t* Z = (bf16_t*)(((unsigned char*)p->ws) + WS_Z); bf16_t* CK = (bf16_t*)(((unsigned char*)p->ws) + WS_CKVN);
    const float* RT = (const float*)(((unsigned char*)p->ws) + WS_ROPE);
    const float* gq = ((const float*)p->in[I_QG]) + l * 192; const float* gkv = ((const float*)p->in[I_KVG]) + l * 512; const float* gnq = ((const float*)p->in[I_NAQG]) + l * 128; const float* gnk = ((const float*)p->in[I_NAKG]) + l * 128;
    float* out = (float*)p->out;
    const int lane = c.lane, g = lane >> 4, li = lane & 15;
    const bool qact = li < 12;
    float gqv[16], gkvv[8], gnqv[8], gnkv[8];
#pragma unroll
    for (int j = 0; j < 16; ++j) gqv[j] = qact ? gq[16 * li + j] : 0.f;
#pragma unroll
    for (int j = 0; j < 8; ++j) { gkvv[j] = gkv[8 * lane + j]; gnqv[j] = gnq[8 * li + j]; gnkv[j] = gnk[8 * li + j]; }
    for (int row = c.bid * 8 + c.wid; row < NTOK + NCACHE; row += c.G * 8) {
        if (row >= NTOK) {
            const int cr = row - NTOK, b = cr >> 9, pp = cr & 511;
            const float* s = ((const float*)p->in[I_CCKV]) + (((size_t)b * 4 + l) * 512 + pp) * 512 + lane * 8;
            const f32x4 a = *(const f32x4*)s, bq = *(const f32x4*)(s + 4);
            u32x4 w; w.x = pk2(a[0], a[1]); w.y = pk2(a[2], a[3]); w.z = pk2(bq[0], bq[1]); w.w = pk2(bq[2], bq[3]);
            *(u32x4*)(CK + (size_t)row * 512 + lane * 8) = w;
            continue;
        }
        bf16_t* zr = Z + (size_t)row * LDZ;
        const bool lat = row >= NTC;
        const int t = (row - NTC) & 4095, grow = t >> 6, gcol = t & 63;
        const int bb = row >> 8, ss_ = row & 255;
        const size_t obase = ((size_t)bb * 4 + l) * 256 + ss_;
        u32x4 qw[2][2], ckw, nqw[2], nkw[2], nvw[2]; bf16_t kpev = 0;
#pragma unroll
        for (int pass = 0; pass < 2; ++pass) { const bf16_t* q = zr + ZC_MQ + (4 * pass + g) * 192 + 16 * li;
            qw[pass][0] = (u32x4){0u, 0u, 0u, 0u}; qw[pass][1] = qw[pass][0];
            if (qact) { qw[pass][0] = *(const u32x4*)q; qw[pass][1] = *(const u32x4*)(q + 8); }
            nqw[pass] = *(const u32x4*)(zr + ZC_NQ + (4 * pass + g) * 128 + 8 * li); nkw[pass] = *(const u32x4*)(zr + ZC_NK + (4 * pass + g) * 128 + 8 * li);
            nvw[pass] = (u32x4){0u, 0u, 0u, 0u}; if (!lat) nvw[pass] = *(const u32x4*)(zr + ZC_NV + (4 * pass + g) * 128 + 8 * li); }
        ckw = *(const u32x4*)(zr + ZC_CKV + 8 * lane);
        if (!lat) kpev = ((const bf16_t*)(((unsigned char*)p->ws) + WS_KPE))[(size_t)row * 64 + lane];
        { float e[8]; unpack8(ckw, e); float s = 0.f;
#pragma unroll
            for (int j = 0; j < 8; ++j) s += e[j] * e[j];
            s = wave_sum16(s, lane); const float ri = rsqrtf(s * (1.0f / 512.0f) + EPS);
#pragma unroll
            for (int j = 0; j < 8; ++j) e[j] = e[j] * ri * gkvv[j];
            *(u32x4*)(CK + (size_t)row * 512 + 8 * lane) = pack8f(e);
            if (!lat) { float* o = out + O_CKV + obase * 512 + 8 * lane; *(f32x4*)o = (f32x4){e[0], e[1], e[2], e[3]}; *(f32x4*)(o + 4) = (f32x4){e[4], e[5], e[6], e[7]}; } }
        if (!lat) out[O_KPE + obase * 64 + lane] = bf2f(kpev);
#pragma unroll
        for (int pass = 0; pass < 2; ++pass) { const int h = 4 * pass + g;
            { bf16_t* k = zr + ZC_NK + h * 128 + 8 * li; float e[8]; unpack8(nkw[pass], e); float s = 0.f;
#pragma unroll
              for (int j = 0; j < 8; ++j) s += e[j] * e[j];
              s = group16_sum(s); const float ri = rsqrtf(s * (1.0f / 128.0f) + EPS);
#pragma unroll
              for (int j = 0; j < 8; ++j) e[j] = e[j] * ri * gnkv[j];
              *(u32x4*)k = pack8f(e);
              if (!lat) { float* o = out + O_NAK + (obase * 8 + h) * 128 + 8 * li; *(f32x4*)o = (f32x4){e[0], e[1], e[2], e[3]}; *(f32x4*)(o + 4) = (f32x4){e[4], e[5], e[6], e[7]};
                  float v[8]; unpack8(nvw[pass], v);
                  float* ov = out + O_NAV + (obase * 8 + h) * 128 + 8 * li; *(f32x4*)ov = (f32x4){v[0], v[1], v[2], v[3]}; *(f32x4*)(ov + 4) = (f32x4){v[4], v[5], v[6], v[7]}; } }
        }
    }
}

DI int ev_perm(int k) { const int kb = k >> 5, kr = k & 31; return kb * 32 + ((kr >> 2) & 1) * 16 + (kr & 3) + 4 * (kr >> 3); }
DI float clampe(float x) { return fminf(fmaxf(x, -50.f), 50.f); }

DI void phase_prep_hgrn(const Ctx& c0, PkPtr p, int l) {
    const Ctx c = launder(c0);
    const bf16_t* Z = (const bf16_t*)(((unsigned char*)p->ws) + WS_Z);
    unsigned char* HG = ((unsigned char*)p->ws) + WS_HG;
    const float* LOW = (const float*)(((unsigned char*)p->ws) + WS_LOWER);
    const int lane = c.lane, cg = lane & 15, tq = lane >> 4;
    for (int hu = c.bid * 8 + c.wid; hu < 768 * 8 * 2; hu += c.G * 8) {
        const int u = hu >> 1, k0 = 64 * (hu & 1) + 4 * cg;
        const int chunk = u >> 3, h = u & 7;
        const bf16_t* zb = Z + (size_t)(chunk * 32 + 8 * tq) * LDZ + h * 128 + k0;
        bf16_t* VT = (bf16_t*)(HG + HG_VT) + (size_t)u * 4096;
        float* EV = (float*)(HG + HG_EV) + (size_t)u * 512;
        { u32x2 v[8];
#pragma unroll
          for (int i = 0; i < 8; ++i) v[i] = *(const u32x2*)(zb + (size_t)i * LDZ + ZC_HI);
#pragma unroll
          for (int j2 = 0; j2 < 2; ++j2) {
              u32x4 lo, hi;
              lo.x = (v[0][j2] & 0xffffu) | (v[1][j2] << 16); lo.y = (v[2][j2] & 0xffffu) | (v[3][j2] << 16); lo.z = (v[4][j2] & 0xffffu) | (v[5][j2] << 16); lo.w = (v[6][j2] & 0xffffu) | (v[7][j2] << 16);
              hi.x = (v[0][j2] >> 16) | (v[1][j2] & 0xffff0000u); hi.y = (v[2][j2] >> 16) | (v[3][j2] & 0xffff0000u); hi.z = (v[4][j2] >> 16) | (v[5][j2] & 0xffff0000u); hi.w = (v[6][j2] >> 16) | (v[7][j2] & 0xffff0000u);
              *(u32x4*)(VT + (k0 + 2 * j2) * 32 + 8 * tq) = lo; *(u32x4*)(VT + (k0 + 2 * j2 + 1) * 32 + 8 * tq) = hi; } }
        float q[8][4];
#pragma unroll
        for (int i = 0; i < 8; ++i) { const u32x2 w = *(const u32x2*)(zb + (size_t)i * LDZ + ZC_HQ); const float x0 = bflo(w.x), x1 = bfhi(w.x), x2 = bflo(w.y), x3 = bfhi(w.y);
            q[i][0] = x0 * sigmoidf_(x0); q[i][1] = x1 * sigmoidf_(x1); q[i][2] = x2 * sigmoidf_(x2); q[i][3] = x3 * sigmoidf_(x3); }
#pragma unroll
        for (int dir = 0; dir < 2; ++dir) {
            const f32x4 lbv = *(const f32x4*)(LOW + (dir * 4 + l) * 1024 + h * 128 + k0);
            float lf[8][4], kk[8][4];
#pragma unroll
            for (int i = 0; i < 8; ++i) { const u32x2 w = *(const u32x2*)(zb + (size_t)i * LDZ + (dir ? ZC_HFB : ZC_HFF)); const float x[4] = {bflo(w.x), bfhi(w.x), bflo(w.y), bfhi(w.y)};
#pragma unroll
                for (int j = 0; j < 4; ++j) { const float e = __expf(-x[j]), s = 1.0f / (1.0f + e); const float f = lbv[j] + (1.0f - lbv[j]) * s;
                    lf[i][j] = fmaxf(__log2f(f), -100.f); kk[i][j] = (1.0f - lbv[j]) * (e * s); } }
            if (dir == 0) {
#pragma unroll
                for (int i = 1; i < 8; ++i)
#pragma unroll
                    for (int j = 0; j < 4; ++j) lf[i][j] += lf[i - 1][j];
            } else {
#pragma unroll
                for (int i = 6; i >= 0; --i)
#pragma unroll
                    for (int j = 0; j < 4; ++j) lf[i][j] += lf[i + 1][j];
            }
            float off[4], mid[4], last[4];
#pragma unroll
            for (int j = 0; j < 4; ++j) { const float own = dir == 0 ? lf[7][j] : lf[0][j];
                const float x16 = shfl_xor_l(own, 16, lane), x32 = shfl_xor_l(own, 32, lane), x48 = shfl_xor_l(own, 48, lane);
                const float t0 = tq == 0 ? own : tq == 1 ? x16 : tq == 2 ? x32 : x48;
                const float t1 = tq == 1 ? own : tq == 0 ? x16 : tq == 3 ? x32 : x48;
                const float t2 = tq == 2 ? own : tq == 3 ? x16 : tq == 0 ? x32 : x48;
                const float t3 = tq == 3 ? own : tq == 2 ? x16 : tq == 1 ? x32 : x48;
                if (dir == 0) { off[j] = (tq > 0 ? t0 : 0.f) + (tq > 1 ? t1 : 0.f) + (tq > 2 ? t2 : 0.f); mid[j] = t0 + t1; }
                else { off[j] = (tq < 3 ? t3 : 0.f) + (tq < 2 ? t2 : 0.f) + (tq < 1 ? t1 : 0.f); mid[j] = t2 + t3; }
                last[j] = t0 + t1 + t2 + t3; }
            bf16_t* QT = (bf16_t*)(HG + (dir ? HG_QTB : HG_QTF)) + (size_t)u * 4096; bf16_t* KT = (bf16_t*)(HG + (dir ? HG_KTB : HG_KTF)) + (size_t)u * 4096; bf16_t* KTT = (bf16_t*)(HG + (dir ? HG_KTTB : HG_KTTF)) + (size_t)u * 4096;
#pragma unroll
            for (int i = 0; i < 8; ++i) { float qo[4];
#pragma unroll
                for (int j = 0; j < 4; ++j) { const float b_ = lf[i][j] + off[j]; qo[j] = q[i][j] * exp2f(clampe(b_ - mid[j])); kk[i][j] = kk[i][j] * exp2f(clampe(mid[j] - b_)); }
                u32x2 wq; wq.x = pk2(qo[0], qo[1]); wq.y = pk2(qo[2], qo[3]); *(u32x2*)(QT + (8 * tq + i) * 128 + k0) = wq;
                u32x2 wk; wk.x = pk2(kk[i][0], kk[i][1]); wk.y = pk2(kk[i][2], kk[i][3]); *(u32x2*)(KT + (8 * tq + i) * 128 + k0) = wk; }
#pragma unroll
            for (int j = 0; j < 4; ++j) { u32x4 w; w.x = pk2(kk[0][j], kk[1][j]); w.y = pk2(kk[2][j], kk[3][j]); w.z = pk2(kk[4][j], kk[5][j]); w.w = pk2(kk[6][j], kk[7][j]);
                *(u32x4*)(KTT + (k0 + j) * 32 + 8 * tq) = w; }
            if (tq == 0) {
#pragma unroll
                for (int j = 0; j < 4; ++j) { const int pi = ev_perm(k0 + j); EV[dir * 256 + pi] = exp2f(mid[j]); EV[dir * 256 + 128 + pi] = exp2f(last[j] - mid[j]); } }
        }
    }
}

DI void phase_kfinal(const Ctx& c0, PkPtr p, int l) {
    const Ctx c = launder(c0);
    const bf16_t* Z = (const bf16_t*)(((unsigned char*)p->ws) + WS_Z); const bf16_t* KV = (const bf16_t*)(((unsigned char*)p->ws) + WS_KVRAW); bf16_t* KB = (bf16_t*)(((unsigned char*)p->ws) + WS_KBUF);
    const float* RT = (const float*)(((unsigned char*)p->ws) + WS_ROPE);
    const float* gk = ((const float*)p->in[I_KG]) + l * 192; const int lane = c.lane, g = lane >> 4, li = lane & 15;
    float gn[8], gp[4];
#pragma unroll
    for (int j = 0; j < 8; ++j) gn[j] = gk[8 * li + j];
#pragma unroll
    for (int j = 0; j < 4; ++j) gp[j] = gk[128 + 4 * li + j];
    for (int row = c.bid * 8 + c.wid; row < NKV; row += c.G * 8) {
        const bool lat = row >= NTC && row < NTOK;
        float pe[4];
        if (row < NTOK) { const u32x2 w = *(const u32x2*)((const bf16_t*)(((unsigned char*)p->ws) + WS_KPE) + (size_t)row * 64 + 4 * li); pe[0] = bflo(w.x); pe[1] = bfhi(w.x); pe[2] = bflo(w.y); pe[3] = bfhi(w.y); }
        else { const int cr = row - NTOK, b = cr >> 9, pp = cr & 511; const f32x4 w = *(const f32x4*)(((const float*)p->in[I_CKPE]) + (((size_t)b * 4 + l) * 512 + pp) * 64 + 4 * li); pe[0] = w[0]; pe[1] = w[1]; pe[2] = w[2]; pe[3] = w[3]; }
        f32x4 rc = {1.f, 1.f, 1.f, 1.f}, rs = {0.f, 0.f, 0.f, 0.f};
        if (lat) { const int t = (row - NTC) & 4095; const int pos = li < 8 ? (t >> 6) : (t & 63); rc = *(const f32x4*)(RT + pos * 16 + ((4 * li) & 15)); rs = *(const f32x4*)(RT + 1024 + pos * 16 + ((4 * li) & 15)); }
        const float pe2 = group16_sum(pe[0] * pe[0] + pe[1] * pe[1] + pe[2] * pe[2] + pe[3] * pe[3]);
        u32x4 knw[2];
#pragma unroll
        for (int pass = 0; pass < 2; ++pass) knw[pass] = *(const u32x4*)(KV + (size_t)row * 2048 + (4 * pass + g) * 128 + 8 * li);
#pragma unroll
        for (int pass = 0; pass < 2; ++pass) { const int h = 4 * pass + g;
            float e[8]; unpack8(knw[pass], e); float s = 0.f;
#pragma unroll
            for (int j = 0; j < 8; ++j) s += e[j] * e[j];
            s = group16_sum(s) + pe2; const float ri = rsqrtf(s * (1.0f / 192.0f) + EPS);
#pragma unroll
            for (int j = 0; j < 8; ++j) e[j] = e[j] * ri * gn[j];
            float y[4];
#pragma unroll
            for (int j = 0; j < 4; ++j) { float v = pe[j] * ri * gp[j]; const float pr = shfl_xor_l(v, 4, lane);
                y[j] = (li & 4) ? pr * rs[j] + v * rc[j] : v * rc[j] - pr * rs[j]; }
            bf16_t* o = KB + ((size_t)row * 8 + h) * 192;
            *(u32x4*)(o + 8 * li) = pack8f(e);
            u32x2 w; w.x = pk2(y[0], y[1]); w.y = pk2(y[2], y[3]); *(u32x2*)(o + 128 + 4 * li) = w; }
    }
}

DI void phase_hg_combine(const Ctx& c0, PkPtr p, int l) {
    const Ctx c = launder(c0);
    bf16_t* Z = (bf16_t*)(((unsigned char*)p->ws) + WS_Z); bf16_t* OBR = (bf16_t*)(((unsigned char*)p->ws) + WS_OBR); const float* gg = ((const float*)p->in[I_HGG]) + l * 128; const int lane = c.lane, g = lane >> 4, li = lane & 15;
    float gv[8];
#pragma unroll
    for (int j = 0; j < 8; ++j) gv[j] = gg[8 * li + j];
    for (int row = c.bid * 8 + c.wid; row < NTOK; row += c.G * 8) {
        bf16_t* zr = Z + (size_t)row * LDZ;
#pragma unroll
        for (int pass = 0; pass < 2; ++pass) { const int h = 4 * pass + g;
            float a[8], b[8], x[8]; unpack8(*(const u32x4*)(zr + ZC_OF + h * 128 + 8 * li), a); unpack8(*(const u32x4*)(zr + ZC_OB + h * 128 + 8 * li), b); unpack8(*(const u32x4*)(zr + ZC_HG + h * 128 + 8 * li), x);
            float s = 0.f;
#pragma unroll
            for (int j = 0; j < 8; ++j) { a[j] += b[j]; s += a[j] * a[j]; }
            s = group16_sum(s); const float ri = rsqrtf(s * (1.0f / 128.0f) + EPS);
#pragma unroll
            for (int j = 0; j < 8; ++j) a[j] = a[j] * ri * gv[j] * (x[j] * sigmoidf_(x[j]));
            *(u32x4*)(OBR + (size_t)row * LDO + 1024 + h * 128 + 8 * li) = pack8f(a); }
    }
}

DI void phase_conv_fix(const Ctx& c0, PkPtr p, int l) {
    const Ctx c = launder(c0);
    bf16_t* ACT = (bf16_t*)(((unsigned char*)p->ws) + WS_ACT); const float* EDGE = (const float*)(((unsigned char*)p->ws) + WS_EDGE);
    const float* cw = ((const float*)p->in[I_CONVW]) + (size_t)l * 3 * FFN;
    const int nvec = FFN / 4;
    for (int it = c.bid * 512 + c.tid; it < 191 * nvec; it += c.G * 512) {
        const int k = 1 + it / nvec, col = (it % nvec) * 4;
        const int T = 128 * k;
        const bool seqstart = T < NTC ? ((T & 255) == 0) : (((T - NTC) & 4095) == 0);
        if (seqstart) continue;
        const float* eL = EDGE + ((size_t)((k - 1) * 2 + 1) * 3) * FFN + col;
        const float* eF = EDGE + ((size_t)(k * 2 + 0) * 3) * FFN + col;
        const f32x4 yL = *(const f32x4*)eL, aL = *(const f32x4*)(eL + FFN), gL = *(const f32x4*)(eL + 2 * FFN);
        const f32x4 yF = *(const f32x4*)eF, aF = *(const f32x4*)(eF + FFN), gF = *(const f32x4*)(eF + 2 * FFN);
        const f32x4 w0 = *(const f32x4*)(cw + col), w2 = *(const f32x4*)(cw + 2 * FFN + col);
        float oL[4], oF[4];
#pragma unroll
        for (int j = 0; j < 4; ++j) { const float y1 = yL[j] + w2[j] * gF[j]; oL[j] = y1 * sigmoidf_(y1) * aL[j]; const float y2 = yF[j] + w0[j] * gL[j]; oF[j] = y2 * sigmoidf_(y2) * aF[j]; }
        u32x2 wl_; wl_.x = pk2(oL[0], oL[1]); wl_.y = pk2(oL[2], oL[3]); *(u32x2*)(ACT + (size_t)(T - 1) * FFN + col) = wl_;
        u32x2 wf_; wf_.x = pk2(oF[0], oF[1]); wf_.y = pk2(oF[2], oF[3]); *(u32x2*)(ACT + (size_t)T * FFN + col) = wf_;
    }
}
namespace att {
constexpr int NW = 8, QBLK = 32, KVBLK = 64;
constexpr int SHM_V = KVBLK * 128 * 2, SHM_K = KVBLK * 128 * 2, SHM_KR = KVBLK * 64 * 2;
constexpr int OFF_V = 0, OFF_K = 2 * SHM_V, OFF_KR = OFF_K + 2 * SHM_K, OFF_WS = OFF_KR + 2 * SHM_KR, OFF_QR = OFF_WS + NW * 256, OFF_RPB = OFF_QR + NW * 4096, LDS_END = OFF_RPB + 2048;
constexpr float LOG2E = 1.4426950408889634f;
constexpr float THR = 8.f;
#define KSWZ(row, colB) ((row) * 256 + ((colB) ^ (((row) & 7) << 4)))
#define KRSWZ(row, colB) ((row) * 128 + ((colB) ^ (((row) & 7) << 4)))
#define SBAR() __builtin_amdgcn_sched_barrier(0)
DI int crow(int r, int hi) { return (r & 3) + 8 * (r >> 2) + 4 * hi; }

struct Src {
    const bf16_t* k0; const bf16_t* v0; int ldk0, ldv0, n0;
    const bf16_t* k1; const bf16_t* v1; int ldk1, ldv1;
    int rowclamp;
    DI void get(int j, const bf16_t*& kp, const bf16_t*& vp, int& ldk, int& ldv) const {
        if (j < n0) { const int jj = j < rowclamp ? j : rowclamp; kp = k0 + (size_t)jj * 64 * ldk0; vp = v0 + (size_t)jj * 64 * ldv0; ldk = ldk0; ldv = ldv0; }
        else { kp = k1 + (size_t)(j - n0) * 64 * ldk1; vp = v1 + (size_t)(j - n0) * 64 * ldv1; ldk = ldk1; ldv = ldv1; }
    }
};
struct NaInfo { int nloc, lo, qrow; const LAS float* rpb; };
struct QPrep { const float* gain; const float* rope; int tok0; };

DI void partialSM(f32x16& p0, f32x16& p1, float& m_reg, float& mn, float& alpha, const float C, const float thr_raw) {
    float pmax = p0[0];
#pragma unroll
    for (int r = 1; r < 16; ++r) pmax = fmaxf(pmax, p0[r]);
#pragma unroll
    for (int r = 0; r < 16; ++r) pmax = fmaxf(pmax, p1[r]);
    { auto rr = __builtin_amdgcn_permlane32_swap(__float_as_uint(pmax), __float_as_uint(pmax), false, false);
      pmax = fmaxf(__uint_as_float(rr[0]), __uint_as_float(rr[1])); }
    if (__builtin_expect(__all(pmax - m_reg <= thr_raw), 1)) { mn = m_reg; alpha = 1.f; }
    else { mn = fmaxf(m_reg, pmax); alpha = __builtin_amdgcn_exp2f((m_reg - mn) * C); m_reg = mn; }
    const float mnC = -mn * C;
#pragma unroll
    for (int r = 0; r < 16; ++r) p0[r] = fmaf(p0[r], C, mnC);
#pragma unroll
    for (int r = 0; r < 16; ++r) p1[r] = fmaf(p1[r], C, mnC);
#pragma unroll
    for (int r = 0; r < 16; ++r) p0[r] = __builtin_amdgcn_exp2f(p0[r]);
}
DI void finishSM(f32x16& p0, f32x16& p1, float alpha, float& l_reg, bf16x8& pa0, bf16x8& pa1, bf16x8& pa2, bf16x8& pa3) {
#pragma unroll
    for (int r = 0; r < 16; ++r) p1[r] = __builtin_amdgcn_exp2f(p1[r]);
    float ps = 0;
#pragma unroll
    for (int r = 0; r < 16; ++r) ps += p0[r];
#pragma unroll
    for (int r = 0; r < 16; ++r) ps += p1[r];
    { auto rr = __builtin_amdgcn_permlane32_swap(__float_as_uint(ps), __float_as_uint(ps), false, false);
      ps = __uint_as_float(rr[0]) + __uint_as_float(rr[1]); }
    l_reg = l_reg * alpha + ps;
#define PK4(P, BASE, OUT) do { unsigned a0 = pk2(P[BASE + 0], P[BASE + 1]), a1 = pk2(P[BASE + 2], P[BASE + 3]);   \
    unsigned b0 = pk2(P[BASE + 4], P[BASE + 5]), b1 = pk2(P[BASE + 6], P[BASE + 7]);                              \
    auto r0 = __builtin_amdgcn_permlane32_swap(a0, b0, false, false); auto r1 = __builtin_amdgcn_permlane32_swap(a1, b1, false, false); \
    u32x4 w = {r0[0], r1[0], r0[1], r1[1]}; OUT = __builtin_bit_cast(bf16x8, w); } while (0)
    PK4(p0, 0, pa0); PK4(p0, 8, pa1); PK4(p1, 0, pa2); PK4(p1, 8, pa3);
#undef PK4
}
template <int KIND>
DI void qkt(f32x16& p0, f32x16& p1, const char* Ks, const char* Krs, const bf16x8* qr, const LAS char* qrope, int r32, int hi) {
    p0 = f32x16{}; p1 = f32x16{};
#pragma unroll
    for (int d0 = 0; d0 < 8; ++d0) { const int cb = (d0 * 16 + hi * 8) * 2;
        const bf16x8 b0 = *reinterpret_cast<const bf16x8*>(Ks + KSWZ(r32, cb));
        const bf16x8 b1 = *reinterpret_cast<const bf16x8*>(Ks + KSWZ(32 + r32, cb));
        p0 = __builtin_amdgcn_mfma_f32_32x32x16_bf16(b0, qr[d0], p0, 0, 0, 0);
        p1 = __builtin_amdgcn_mfma_f32_32x32x16_bf16(b1, qr[d0], p1, 0, 0, 0); }
    if constexpr (KIND == 0) {
#pragma unroll
        for (int d0 = 0; d0 < 4; ++d0) { const int cb = (d0 * 16 + hi * 8) * 2;
            const bf16x8 b0 = *reinterpret_cast<const bf16x8*>(Krs + KRSWZ(r32, cb));
            const bf16x8 b1 = *reinterpret_cast<const bf16x8*>(Krs + KRSWZ(32 + r32, cb));
            const bf16x8 qq = *reinterpret_cast<const LAS bf16x8*>(qrope + d0 * 1024);
            p0 = __builtin_amdgcn_mfma_f32_32x32x16_bf16(b0, qq, p0, 0, 0, 0);
            p1 = __builtin_amdgcn_mfma_f32_32x32x16_bf16(b1, qq, p1, 0, 0, 0); }
    }
}
DI void na_fix(f32x16& p0, f32x16& p1, int j, const NaInfo& na, const float C, int qc, int hi) {
    const float NEGM = -3.0e38f;
    if (j >= na.nloc) {
        const bool dummy = false;
#pragma unroll
        for (int r = 0; r < 16; ++r) { p0[r] *= C; p1[r] *= C; }
        (void)dummy; return;
    }
    const int kr = na.lo + j, q = na.qrow;
    const int rs = q - 4 < 0 ? 0 : (q - 4 > 56 ? 56 : q - 4);
    const bool rowin = (kr >= rs) && (kr < rs + 8);
    const int dr = kr - q + 7;
    const int cs = qc - 8 < 0 ? 0 : (qc - 8 > 48 ? 48 : qc - 8);
    const LAS float* bt = na.rpb + (rowin ? dr : 0) * 31 + 15;
#pragma unroll
    for (int r = 0; r < 16; ++r) {
        { const int kc = crow(r, hi); int dc = kc - qc; dc = dc < -15 ? -15 : (dc > 15 ? 15 : dc);
          const bool ok = rowin && kc >= cs && kc < cs + 16; p0[r] = ok ? fmaf(p0[r], C, bt[dc]) : NEGM; }
        { const int kc = 32 + crow(r, hi); int dc = kc - qc; dc = dc < -15 ? -15 : (dc > 15 ? 15 : dc);
          const bool ok = rowin && kc >= cs && kc < cs + 16; p1[r] = ok ? fmaf(p1[r], C, bt[dc]) : NEGM; }
    }
}
DI int v_st(int k, int c) { const int kk = (k & ~0xC) | ((k & 4) << 1) | ((k & 8) >> 1); return ((kk >> 3) * 4 + (c >> 5)) * 512 + ((kk & 7) * 32 + (c & 31)) * 2; }
DI int v_rd_base(int lane) { return ((lane & 3) << 3) | (((lane >> 2) & 3) << 6) | (((lane >> 4) & 1) << 5) | (((lane >> 5) & 1) << 8); }
constexpr int v_rd_off(int d0, int ks, int half) { return d0 * 512 + ks * 4096 + half * 2048; }
template <int OFF> DI s16x4 tr_read(int vb) { s16x4 r; asm volatile("ds_read_b64_tr_b16 %0, %1 offset:%2" : "=&v"(r) : "v"(vb), "i"(OFF) : "memory"); return r; }
template <int D0> DI void pv_one(f32x16& od, int vb, bf16x8 pa0, bf16x8 pa1, bf16x8 pa2, bf16x8 pa3) {
    const s16x4 l0 = tr_read<v_rd_off(D0, 0, 0)>(vb), h0 = tr_read<v_rd_off(D0, 0, 1)>(vb), l1 = tr_read<v_rd_off(D0, 1, 0)>(vb), h1 = tr_read<v_rd_off(D0, 1, 1)>(vb);
    const s16x4 l2 = tr_read<v_rd_off(D0, 2, 0)>(vb), h2 = tr_read<v_rd_off(D0, 2, 1)>(vb), l3 = tr_read<v_rd_off(D0, 3, 0)>(vb), h3 = tr_read<v_rd_off(D0, 3, 1)>(vb);
    asm volatile("s_waitcnt lgkmcnt(0)" ::: "memory"); SBAR();
#define PK(L, H) (bf16x8){L[0], L[1], L[2], L[3], H[0], H[1], H[2], H[3]}
    od = __builtin_amdgcn_mfma_f32_32x32x16_bf16(pa0, PK(l0, h0), od, 0, 0, 0);
    od = __builtin_amdgcn_mfma_f32_32x32x16_bf16(pa1, PK(l1, h1), od, 0, 0, 0);
    od = __builtin_amdgcn_mfma_f32_32x32x16_bf16(pa2, PK(l2, h2), od, 0, 0, 0);
    od = __builtin_amdgcn_mfma_f32_32x32x16_bf16(pa3, PK(l3, h3), od, 0, 0, 0);
#undef PK
}
DI void pv_d0(f32x16* o, int vb, bf16x8 pa0, bf16x8 pa1, bf16x8 pa2, bf16x8 pa3) {
    pv_one<0>(o[0], vb, pa0, pa1, pa2, pa3); pv_one<1>(o[1], vb, pa0, pa1, pa2, pa3); pv_one<2>(o[2], vb, pa0, pa1, pa2, pa3); pv_one<3>(o[3], vb, pa0, pa1, pa2, pa3);
}

template <int KIND>
DI void attn_unit(const bf16_t* __restrict__ Qb, int ldq, bf16_t* __restrict__ Ob, int ldo, const Src src, int NT, const float scale, const NaInfo na, const QPrep qp, char* lds) {
    int tid_ = threadIdx.x; asm volatile("" : "+v"(tid_));
    const int tid = tid_, wid = __builtin_amdgcn_readfirstlane(tid >> 6), lane = tid & 63, r32 = lane & 31, hi = lane >> 5;
    char* V_lds = lds + OFF_V; char* K_lds = lds + OFF_K; char* KR_lds = lds + OFF_KR;
    float* ws = (float*)(lds + OFF_WS) + wid * 64; float* li_l = ws; float* al_l = ws + 32;
    const LAS char* qrope = (const LAS char*)(lds + OFF_QR + wid * 4096 + lane * 16);
    const float C = (KIND == 2) ? 1.0f : scale * LOG2E;
    const float CN = scale * LOG2E;
    const float thr_raw = (KIND == 2) ? THR * LOG2E : THR / scale;
    float m_reg = -1e30f, l_reg = 0; f32x16 o[4] = {}; bf16x8 qr[8];
    const bf16_t* Qw = Qb + (size_t)(wid * QBLK + r32) * ldq + hi * 8;
    {
        u32x4 raw[KIND == 0 ? 12 : 8];
#pragma unroll
        for (int d0 = 0; d0 < (KIND == 0 ? 12 : 8); ++d0) raw[d0] = *reinterpret_cast<const u32x4*>(Qw + d0 * 16);
        float ss = 0.f;
#pragma unroll
        for (int d0 = 0; d0 < (KIND == 0 ? 12 : 8); ++d0) { float e[8]; unpack8(raw[d0], e);
#pragma unroll
            for (int j = 0; j < 8; ++j) ss += e[j] * e[j]; }
        { auto rr = __builtin_amdgcn_permlane32_swap(__float_as_uint(ss), __float_as_uint(ss), false, false); ss = __uint_as_float(rr[0]) + __uint_as_float(rr[1]); }
        const float ri = rsqrtf(ss * (KIND == 0 ? (1.0f / 192.0f) : (1.0f / 128.0f)) + EPS);
#pragma unroll
        for (int d0 = 0; d0 < 8; ++d0) { float e[8]; unpack8(raw[d0], e);
            const f32x4 g0 = *(const f32x4*)(qp.gain + d0 * 16 + hi * 8), g1 = *(const f32x4*)(qp.gain + d0 * 16 + hi * 8 + 4);
#pragma unroll
            for (int j = 0; j < 4; ++j) { e[j] = e[j] * ri * g0[j]; e[4 + j] = e[4 + j] * ri * g1[j]; }
            const u32x4 w = pack8f(e); qr[d0] = __builtin_bit_cast(bf16x8, w); }
        if constexpr (KIND == 0) {
            float y[4][8];
#pragma unroll
            for (int d0 = 0; d0 < 4; ++d0) { unpack8(raw[8 + d0], y[d0]);
                const f32x4 g0 = *(const f32x4*)(qp.gain + 128 + d0 * 16 + hi * 8), g1 = *(const f32x4*)(qp.gain + 128 + d0 * 16 + hi * 8 + 4);
#pragma unroll
                for (int j = 0; j < 4; ++j) { y[d0][j] = y[d0][j] * ri * g0[j]; y[d0][4 + j] = y[d0][4 + j] * ri * g1[j]; } }
            if (qp.rope) { const int t = qp.tok0 + wid * QBLK + r32;
#pragma unroll
                for (int pr = 0; pr < 2; ++pr) { const int pos = pr == 0 ? (t >> 6) : (t & 63);
                    const f32x4 c0 = *(const f32x4*)(qp.rope + pos * 16 + hi * 8), c1 = *(const f32x4*)(qp.rope + pos * 16 + hi * 8 + 4);
                    const f32x4 s0 = *(const f32x4*)(qp.rope + 1024 + pos * 16 + hi * 8), s1 = *(const f32x4*)(qp.rope + 1024 + pos * 16 + hi * 8 + 4);
#pragma unroll
                    for (int j = 0; j < 8; ++j) { const float cc = j < 4 ? c0[j & 3] : c1[j & 3], sn = j < 4 ? s0[j & 3] : s1[j & 3];
                        const float x1 = y[2 * pr][j], x2 = y[2 * pr + 1][j];
                        y[2 * pr][j] = x1 * cc - x2 * sn; y[2 * pr + 1][j] = x1 * sn + x2 * cc; } } }
#pragma unroll
            for (int d0 = 0; d0 < 4; ++d0) { const u32x4 w = pack8f(y[d0]); *(LAS u32x4*)(lds + OFF_QR + wid * 4096 + lane * 16 + d0 * 1024) = w; }
        }
    }
    const int qc = (wid & 1) * 32 + r32;
    const int vb0 = (int)(uintptr_t)(LAS char*)(V_lds) + v_rd_base(lane);
    int kofs[2], vrow[2], vcol[2], krofs;
#pragma unroll
    for (int i = 0; i < 2; ++i) { const int sl = tid + 512 * i;
        { const int row = sl >> 4, cch = (sl & 15) ^ (row & 7); kofs[i] = (row << 16) | (cch * 8); }
        { const int sub = sl >> 5, w = sl & 31, kk = (sub >> 2) * 8 + (w >> 2); vrow[i] = (kk & ~0xC) | ((kk & 4) << 1) | ((kk & 8) >> 1); vcol[i] = (sub & 3) * 32 + (w & 3) * 8; } }
    { const int row = tid >> 3, cch = (tid & 7) ^ (row & 7); krofs = (row << 16) | (128 + cch * 8); }
    const unsigned slot0 = (unsigned)wid * 1024u;
#define SDMA(jt, bb) do { const bf16_t *kp_, *vp_; int ldk_, ldv_; src.get((jt), kp_, vp_, ldk_, ldv_); \
    _Pragma("unroll") for (int i_ = 0; i_ < 2; ++i_) { \
        __builtin_amdgcn_global_load_lds((const unsigned*)(kp_ + (size_t)(kofs[i_] >> 16) * ldk_ + (kofs[i_] & 0xffff)), (LAS unsigned*)(K_lds + (bb) * SHM_K + slot0 + i_ * 8192), 16, 0, 0); \
        __builtin_amdgcn_global_load_lds((const unsigned*)(vp_ + (size_t)vrow[i_] * ldv_ + vcol[i_]), (LAS unsigned*)(V_lds + (bb) * SHM_V + slot0 + i_ * 8192), 16, 0, 0); } \
    if constexpr (KIND == 0) __builtin_amdgcn_global_load_lds((const unsigned*)(kp_ + (size_t)(krofs >> 16) * ldk_ + (krofs & 0xffff)), (LAS unsigned*)(KR_lds + (bb) * SHM_KR + slot0), 16, 0, 0); } while (0)
    SDMA(0, 0); asm volatile("s_waitcnt vmcnt(0)" ::: "memory");
#pragma unroll
    for (int d0 = 0; d0 < 8; ++d0) asm volatile("" : "+v"(qr[d0]));
    __syncthreads();
    for (int j = 0; j < NT; ++j) {
        const int b = j & 1;
        f32x16 p0, p1; float mn, al; bf16x8 pa0, pa1, pa2, pa3;
        if (j + 1 < NT) SDMA(j + 1, b ^ 1);
        SBAR();
        bool skip = false;
        if constexpr (KIND == 2) { if (j < na.nloc) { const int kr = na.lo + j, q_ = na.qrow; const int rs_ = q_ - 4 < 0 ? 0 : (q_ - 4 > 56 ? 56 : q_ - 4); skip = !(kr >= rs_ && kr < rs_ + 8); } }
        if (!skip) {
        qkt<KIND>(p0, p1, K_lds + b * SHM_K, KR_lds + b * SHM_KR, qr, qrope, r32, hi);
        if constexpr (KIND == 2) na_fix(p0, p1, j, na, CN, qc, hi);
        partialSM(p0, p1, m_reg, mn, al, C, thr_raw);
        if (__any(al < 1.f)) { if (hi == 0) al_l[r32] = al; asm volatile("s_waitcnt lgkmcnt(0)" ::: "memory");
#pragma unroll
            for (int d = 0; d < 4; ++d)
#pragma unroll
                for (int r = 0; r < 16; ++r) o[d][r] *= al_l[crow(r, hi)]; }
        finishSM(p0, p1, al, l_reg, pa0, pa1, pa2, pa3); SBAR();
        pv_d0(o, vb0 + b * SHM_V, pa0, pa1, pa2, pa3);
        }
        asm volatile("s_waitcnt vmcnt(0)" ::: "memory");
        __syncthreads();
    }
    if (hi == 0) li_l[r32] = l_reg; asm volatile("s_waitcnt lgkmcnt(0)" ::: "memory");
    float rli[16];
#pragma unroll
    for (int r = 0; r < 16; ++r) rli[r] = __builtin_amdgcn_rcpf(li_l[crow(r, hi)]);
    bf16_t* Ow = Ob + (size_t)(wid * QBLK) * ldo;
#pragma unroll
    for (int r = 0; r < 16; ++r) { const int orow = crow(r, hi);
#pragma unroll
        for (int d0 = 0; d0 < 4; ++d0) Ow[(size_t)orow * ldo + d0 * 32 + r32] = f2bf(o[d0][r] * rli[r]); }
    asm volatile("s_waitcnt vmcnt(0) lgkmcnt(0)" ::: "memory");
    __syncthreads();
#undef SDMA
}
}
namespace hg {
DI int crow(int r, int hi) { return (r & 3) + 8 * (r >> 2) + 4 * hi; }
DI bf16x8 pack8(const f32x16& x, int s) {
    u32x4 w; w.x = pk2(x[8 * s + 0], x[8 * s + 1]); w.y = pk2(x[8 * s + 2], x[8 * s + 3]); w.z = pk2(x[8 * s + 4], x[8 * s + 5]); w.w = pk2(x[8 * s + 6], x[8 * s + 7]);
    return __builtin_bit_cast(bf16x8, w);
}
DI bf16x8 ldperm(const bf16_t* rowp, int kk, int hh) {
    const u32x2 a = *(const u32x2*)(rowp + 16 * kk + 4 * hh), b = *(const u32x2*)(rowp + 16 * kk + 8 + 4 * hh);
    u32x4 w = {a.x, a.y, b.x, b.y}; return __builtin_bit_cast(bf16x8, w);
}
#define HMFMA(a, b, c) __builtin_amdgcn_mfma_f32_32x32x16_bf16((a), (b), (c), 0, 0, 0)

constexpr int CH_QT = 0, CH_KT = 8192, CH_KTT = 16384, CH_VT = 24576, CH_EV = 32768, CH_BYTES = 33792, CH_STAGE = 2 * CH_BYTES;
DI bf16x8 lds_perm16(const LAS char* row, int kk, int hh, int swz) {
    const u32x2 a = *(const LAS u32x2*)(row + (((2 * kk) ^ swz) << 4) + 8 * hh), b = *(const LAS u32x2*)(row + (((2 * kk + 1) ^ swz) << 4) + 8 * hh);
    u32x4 w = {a.x, a.y, b.x, b.y}; return __builtin_bit_cast(bf16x8, w);
}
DI void chain_stage(PkPtr p, LAS unsigned char* sb, int dir, int wv, int lane, size_t u) {
    const unsigned char* HG = (const unsigned char*)p->ws + WS_HG;
    const char* gq = (const char*)(HG + (dir ? HG_QTB : HG_QTF)) + u * 8192;
    const char* gk = (const char*)(HG + (dir ? HG_KTB : HG_KTF)) + u * 8192;
    const char* gt = (const char*)(HG + (dir ? HG_KTTB : HG_KTTF)) + u * 8192;
    const char* gv = (const char*)(HG + HG_VT) + u * 8192;
#pragma unroll
    for (int j = 0; j < 2; ++j) {
        const int pi = wv * 64 + lane + 256 * j;
        const int r16 = pi >> 4, c16 = (pi & 15) ^ (r16 & 15);
        const int r4 = pi >> 2, c4 = (pi & 3) ^ ((r4 >> 2) & 3);
        const unsigned lo = (unsigned)(wv * 64 + 256 * j) * 16u;
        __builtin_amdgcn_global_load_lds((const unsigned*)(gq + r16 * 256 + c16 * 16), (LAS unsigned*)(sb + CH_QT + lo), 16, 0, 0);
        __builtin_amdgcn_global_load_lds((const unsigned*)(gk + r16 * 256 + c16 * 16), (LAS unsigned*)(sb + CH_KT + lo), 16, 0, 0);
        __builtin_amdgcn_global_load_lds((const unsigned*)(gt + r4 * 64 + c4 * 16), (LAS unsigned*)(sb + CH_KTT + lo), 16, 0, 0);
        __builtin_amdgcn_global_load_lds((const unsigned*)(gv + r4 * 64 + c4 * 16), (LAS unsigned*)(sb + CH_VT + lo), 16, 0, 0);
    }
    if (wv == 0) { const char* ge = (const char*)(HG + HG_EV) + u * 2048 + dir * 1024;
        __builtin_amdgcn_global_load_lds((const unsigned*)(ge + lane * 16), (LAS unsigned*)(sb + CH_EV), 16, 0, 0); }
}
DI void chain_unit(PkPtr p, LAS unsigned char* lds, int l, bool lat, int b, int h, int tid_) {
    int tid = tid_; asm volatile("" : "+v"(tid));
    const int lane = tid & 63, wid = __builtin_amdgcn_readfirstlane(tid >> 6), dir = wid >> 2, vs = wid & 3;
    const int r = lane & 31, hh = lane >> 5;
    const int tok0 = lat ? NTC + b * 4096 : b * 256, nch = lat ? 128 : 8;
    bf16_t* Z = (bf16_t*)((unsigned char*)p->ws + WS_Z);
    f32x16 S[4];
    if (lat) { const float* s0 = (const float*)p->in[I_SHG] + ((((size_t)b * 4 + l) * 2 + dir) * 8 + h) * (128 * 128) + 32 * vs + r;
#pragma unroll
        for (int kb = 0; kb < 4; ++kb)
#pragma unroll
            for (int i = 0; i < 16; ++i) S[kb][i] = s0[(size_t)(32 * kb + crow(i, hh)) * 128];
    } else {
#pragma unroll
        for (int kb = 0; kb < 4; ++kb) S[kb] = f32x16{};
    }
    const size_t ubase = (size_t)(tok0 / 32) * 8 + h;
    chain_stage(p, lds + dir * CH_BYTES, dir, vs, lane, ubase + (size_t)(dir ? nch - 1 : 0) * 8);
    asm volatile("s_waitcnt vmcnt(0)" ::: "memory"); __syncthreads();
    for (int cc = 0; cc < nch; ++cc) {
        const int ci = dir ? nch - 1 - cc : cc;
        if (cc + 1 < nch) chain_stage(p, lds + ((cc + 1) & 1) * CH_STAGE + dir * CH_BYTES, dir, vs, lane, ubase + (size_t)(dir ? ci - 1 : ci + 1) * 8);
        const LAS char* sb = (const LAS char*)(lds + (cc & 1) * CH_STAGE + dir * CH_BYTES);
        const LAS float* EV = (const LAS float*)(sb + CH_EV);
        const LAS char* qrow = sb + CH_QT + r * 256; const LAS char* krow = sb + CH_KT + r * 256; const int sw16 = r & 15;
        f32x16 pT = f32x16{}, o = f32x16{};
#pragma unroll
        for (int kb = 0; kb < 4; ++kb) {
            const LAS f32x4* e = (const LAS f32x4*)(EV + kb * 32 + hh * 16);
            const f32x4 e0 = e[0], e1 = e[1], e2 = e[2], e3 = e[3];
            const bf16x8 q0 = lds_perm16(qrow, 2 * kb, hh, sw16), k0 = lds_perm16(krow, 2 * kb, hh, sw16);
            const bf16x8 q1 = lds_perm16(qrow, 2 * kb + 1, hh, sw16), k1 = lds_perm16(krow, 2 * kb + 1, hh, sw16);
#pragma unroll
            for (int i = 0; i < 4; ++i) { S[kb][i] *= e0[i]; S[kb][4 + i] *= e1[i]; S[kb][8 + i] *= e2[i]; S[kb][12 + i] *= e3[i]; }
            const bf16x8 s0 = pack8(S[kb], 0), s1 = pack8(S[kb], 1);
            pT = HMFMA(k0, q0, pT); o = HMFMA(q0, s0, o);
            pT = HMFMA(k1, q1, pT); o = HMFMA(q1, s1, o);
            __builtin_amdgcn_sched_barrier(0);
        }
#pragma unroll
        for (int i = 0; i < 16; ++i) { const int s = crow(i, hh); const bool keep = dir ? (s >= r) : (s <= r); pT[i] = keep ? pT[i] : 0.f; }
        const int vr = 32 * vs + r, swv = (vr >> 2) & 3;
        const LAS char* vrow = sb + CH_VT + vr * 64;
        { const u32x2 a0 = *(const LAS u32x2*)(vrow + ((0 ^ swv) << 4) + 8 * hh), b0 = *(const LAS u32x2*)(vrow + ((1 ^ swv) << 4) + 8 * hh);
          const u32x2 a1 = *(const LAS u32x2*)(vrow + ((2 ^ swv) << 4) + 8 * hh), b1 = *(const LAS u32x2*)(vrow + ((3 ^ swv) << 4) + 8 * hh);
          const u32x4 w0 = {a0.x, a0.y, b0.x, b0.y}, w1 = {a1.x, a1.y, b1.x, b1.y};
          o = HMFMA(pack8(pT, 0), __builtin_bit_cast(bf16x8, w0), o);
          o = HMFMA(pack8(pT, 1), __builtin_bit_cast(bf16x8, w1), o); }
        { bf16_t* op = Z + (size_t)(tok0 + ci * 32) * LDZ + (dir ? ZC_OB : ZC_OF) + h * 128 + 32 * vs + r;
#pragma unroll
            for (int i = 0; i < 16; ++i) op[(size_t)crow(i, hh) * LDZ] = f2bf(o[i]); }
        __builtin_amdgcn_sched_barrier(0);
        const bf16x8 v0 = *(const LAS bf16x8*)(vrow + ((hh ^ swv) << 4)), v1 = *(const LAS bf16x8*)(vrow + (((2 + hh) ^ swv) << 4));
        const int swk = (r >> 2) & 3;
#pragma unroll
        for (int kb = 0; kb < 4; ++kb) {
            const LAS char* trow = sb + CH_KTT + (32 * kb + r) * 64;
            const bf16x8 a0 = *(const LAS bf16x8*)(trow + ((hh ^ swk) << 4)), a1 = *(const LAS bf16x8*)(trow + (((2 + hh) ^ swk) << 4));
            S[kb] = HMFMA(a0, v0, S[kb]); S[kb] = HMFMA(a1, v1, S[kb]);
            const LAS f32x4* e = (const LAS f32x4*)(EV + 128 + kb * 32 + hh * 16);
            const f32x4 e0 = e[0], e1 = e[1], e2 = e[2], e3 = e[3];
#pragma unroll
            for (int i = 0; i < 4; ++i) { S[kb][i] *= e0[i]; S[kb][4 + i] *= e1[i]; S[kb][8 + i] *= e2[i]; S[kb][12 + i] *= e3[i]; }
        }
        asm volatile("s_waitcnt vmcnt(0)" ::: "memory"); __syncthreads();
    }
    if (!lat) { float* so = (float*)p->out + O_HGS + ((((size_t)b * 4 + l) * 2 + dir) * 8 + h) * (128 * 128) + 32 * vs + r;
#pragma unroll
        for (int kb = 0; kb < 4; ++kb)
#pragma unroll
            for (int i = 0; i < 16; ++i) so[(size_t)(32 * kb + crow(i, hh)) * 128] = S[kb][i];
    }
    { bf16_t* OBR = (bf16_t*)((unsigned char*)p->ws + WS_OBR); const float* gg = (const float*)p->in[I_HGG] + l * 128;
      const int g4 = lane >> 4, li = lane & 15;
      float gv[8];
#pragma unroll
      for (int j = 0; j < 8; ++j) gv[j] = gg[8 * li + j];
      for (int rr = wid * 4 + g4; rr < nch * 32; rr += 32) {
          const bf16_t* zr = Z + (size_t)(tok0 + rr) * LDZ + h * 128 + 8 * li;
          float a[8], bb[8], x[8]; unpack8(*(const u32x4*)(zr + ZC_OF), a); unpack8(*(const u32x4*)(zr + ZC_OB), bb); unpack8(*(const u32x4*)(zr + ZC_HG), x);
          float s = 0.f;
#pragma unroll
          for (int j = 0; j < 8; ++j) { a[j] += bb[j]; s += a[j] * a[j]; }
          s = group16_sum(s); const float ri = rsqrtf(s * (1.0f / 128.0f) + EPS);
#pragma unroll
          for (int j = 0; j < 8; ++j) a[j] = a[j] * ri * gv[j] * (x[j] * sigmoidf_(x[j]));
          *(u32x4*)(OBR + (size_t)(tok0 + rr) * LDO + 1024 + h * 128 + 8 * li) = pack8f(a); } }
}
#undef HMFMA
}

DI void load_rpb(const Ctx& c, PkPtr p, int l, int h) {
    LAS float* T = (LAS float*)(c.lds + att::OFF_RPB);
    const float* s = ((const float*)p->in[I_RPB]) + ((size_t)l * 8 + h) * (15 * 31);
    for (int i = c.tid; i < 15 * 31; i += 512) T[i] = s[i] * att::LOG2E;
    __syncthreads();
}

constexpr int QW_BASE = 4096;
DI unsigned* qword(PkPtr p, int l, int cat, int q) { return (unsigned*)(((unsigned char*)p->ws) + WS_CTL) + QW_BASE + ((l * 6 + cat) * 8 + q) * 16; }
DI unsigned grab(unsigned* ctr, volatile LAS unsigned* slot, int tid) {
    __syncthreads();
    if (tid == 0) *slot = __hip_atomic_fetch_add(ctr, 1u, __ATOMIC_RELAXED, __HIP_MEMORY_SCOPE_AGENT);
    __syncthreads();
    return (unsigned)__builtin_amdgcn_readfirstlane((int)*slot);
}
DI unsigned peek8(unsigned* ctr0, unsigned n, volatile LAS unsigned* slot, int tid) {
    __syncthreads();
    if (tid < 64) { const unsigned v = tid < 8 ? __hip_atomic_load(ctr0 + 16 * tid, __ATOMIC_RELAXED, __HIP_MEMORY_SCOPE_AGENT) : n;
        const unsigned long long bm = __ballot(v < n); if (tid == 0) *slot = (unsigned)bm & 0xffu; }
    __syncthreads();
    return (unsigned)__builtin_amdgcn_readfirstlane((int)*slot);
}

#ifdef PROBE_MIXQ2
#define QREP 2u
#else
#define QREP 1u
#endif
#ifdef PROBE_MLAQ2
#define QREP1 2u
#else
#define QREP1 QREP
#endif
DI void phase_mixers(const Ctx& c0, PkPtr p, int l, int lq, int bg_first) {
    const Ctx c = launder(c0);
    bf16_t* Z = (bf16_t*)(((unsigned char*)p->ws) + WS_Z); const bf16_t* KB = (const bf16_t*)(((unsigned char*)p->ws) + WS_KBUF); const bf16_t* KV = (const bf16_t*)(((unsigned char*)p->ws) + WS_KVRAW);
    char* lds = (char*)c.lds; bf16_t* OBR = (bf16_t*)(((unsigned char*)p->ws) + WS_OBR);
    const float sc_mla = 0.07216878364870322f, sc_na = 0.08838834764831845f;
    att::NaInfo na0; na0.nloc = 0; na0.lo = 0; na0.qrow = 0; na0.rpb = (const LAS float*)(c.lds + att::OFF_RPB);
    const float* RT_ = (const float*)(((unsigned char*)p->ws) + WS_ROPE);
    const att::QPrep qp_mla_lat0{((const float*)p->in[I_QG]) + l * 192, RT_, 0}, qp_mla_ctx{((const float*)p->in[I_QG]) + l * 192, nullptr, 0}, qp_na{((const float*)p->in[I_NAQG]) + l * 128, nullptr, 0};
    volatile LAS unsigned* slot = (volatile LAS unsigned*)(c.lds + QSLOT_OFF);
    const int x = (int)(xb_xcc_id() & 7u);
#ifndef MIX_MASK
#define MIX_MASK 31
#endif
    if (MIX_MASK & 16) {
        int q = x;
        for (;;) {
            const unsigned u0 = grab(qword(p, lq, 0, q), slot, c.tid); const unsigned u = u0 & 3u;
            if (u0 < 4u * QREP) { const int v = q * 4 + (int)u; hg::chain_unit(p, c.lds, l, true, v >> 3, v & 7, c.tid); continue; }
            const unsigned m = peek8(qword(p, lq, 0, 0), 4u * QREP, slot, c.tid);
            if (!m) break;
            const unsigned rot = ((m >> x) | (m << (8 - x))) & 0xffu; q = (x + __builtin_ctz(rot)) & 7;
        }
    }
    if (MIX_MASK & 1) {
        int q = x;
        for (;;) {
            const unsigned u1 = grab(qword(p, lq, 1, q), slot, c.tid); const unsigned u = u1 & 63u;
            if (u1 < 64u * QREP1) {
                const int pair = q * 4 + (int)(u >> 4), blk = (int)(u & 15u);
                const int b = pair >> 3, h = pair & 7;
                const size_t qrow0 = (size_t)NTC + b * 4096 + blk * 256;
                att::Src s; s.k0 = KB + ((size_t)(NTC + b * 4096) * 8 + h) * 192; s.v0 = KV + (size_t)(NTC + b * 4096) * 2048 + 1024 + h * 128; s.ldk0 = 1536; s.ldv0 = 2048; s.n0 = 64;
                s.k1 = KB + ((size_t)(NTOK + b * 512) * 8 + h) * 192; s.v1 = KV + (size_t)(NTOK + b * 512) * 2048 + 1024 + h * 128; s.ldk1 = 1536; s.ldv1 = 2048; s.rowclamp = 1 << 20;
                att::QPrep qpl = qp_mla_lat0; qpl.tok0 = blk * 256;
                att::attn_unit<0>(Z + qrow0 * LDZ + ZC_MQ + h * 192, LDZ, OBR + qrow0 * LDO + h * 128, LDO, s, 72, sc_mla, na0, qpl, lds);
                continue;
            }
            const unsigned m = peek8(qword(p, lq, 1, 0), 64u * QREP1, slot, c.tid);
            if (!m) break;
            const unsigned rot = ((m >> x) | (m << (8 - x))) & 0xffu; q = (x + __builtin_ctz(rot)) & 7;
        }
    }
    if (MIX_MASK & 2) for (;;) {
        const unsigned u2 = grab(qword(p, lq, 2, 0), slot, c.tid); const unsigned u = u2 & 511u;
        if (u2 >= 512u * QREP) break;
        const int b = u >> 7, h = (u >> 4) & 7, blk = u & 15;
        load_rpb(c, p, l, h);
        const int r0 = blk * 4;
        const int lo = r0 - 4 < 0 ? 0 : (r0 - 4 > 56 ? 56 : r0 - 4);
        const int r3 = r0 + 3; const int rs3 = r3 - 4 < 0 ? 0 : (r3 - 4 > 56 ? 56 : r3 - 4);
        const int nloc = rs3 + 8 - lo, nlp = (nloc + 1) & ~1;
        const size_t qrow0 = (size_t)NTC + b * 4096 + blk * 256, krow0 = (size_t)NTC + b * 4096 + lo * 64;
        att::Src s; s.k0 = Z + krow0 * LDZ + ZC_NK + h * 128; s.v0 = Z + krow0 * LDZ + ZC_NV + h * 128; s.ldk0 = LDZ; s.ldv0 = LDZ; s.n0 = nlp;
        s.k1 = (const bf16_t*)(((unsigned char*)p->ws) + WS_NAKC) + ((size_t)(l * 4 + b) * 512) * 1024 + h * 128; s.v1 = (const bf16_t*)(((unsigned char*)p->ws) + WS_NAVC) + ((size_t)(l * 4 + b) * 512) * 1024 + h * 128; s.ldk1 = 1024; s.ldv1 = 1024;
        s.rowclamp = 63 - lo;
        att::NaInfo na; na.nloc = nlp; na.lo = lo; na.qrow = r0 + (c.wid >> 1); na.rpb = na0.rpb;
        att::attn_unit<2>(Z + qrow0 * LDZ + ZC_NQ + h * 128, LDZ, OBR + qrow0 * LDO + 2048 + h * 128, LDO, s, nlp + 8, sc_na, na, qp_na, lds);
    }
    if (MIX_MASK & 16) for (;;) {
        const unsigned u3 = grab(qword(p, lq, 3, 0), slot, c.tid); const unsigned u = u3 & 255u;
        if (u3 >= 256u * QREP) break;
        hg::chain_unit(p, c.lds, l, false, (int)(u >> 3), (int)(u & 7u), c.tid);
    }
    if (MIX_MASK & 4) for (;;) {
        const unsigned u4 = grab(qword(p, lq, 4, 0), slot, c.tid); const unsigned u = u4 & 255u;
        if (u4 >= 256u * QREP) break;
        const int b = u >> 3, h = u & 7; const size_t row0 = (size_t)b * 256;
        att::Src s; s.k0 = KB + (row0 * 8 + h) * 192; s.v0 = KV + row0 * 2048 + 1024 + h * 128; s.ldk0 = 1536; s.ldv0 = 2048; s.n0 = 4; s.k1 = s.k0; s.v1 = s.v0; s.ldk1 = 1536; s.ldv1 = 2048; s.rowclamp = 1 << 20;
        att::attn_unit<0>(Z + row0 * LDZ + ZC_MQ + h * 192, LDZ, OBR + row0 * LDO + h * 128, LDO, s, 4, sc_mla, na0, qp_mla_ctx, lds);
    }
    if (MIX_MASK & 8) for (;;) {
        const unsigned u5 = grab(qword(p, lq, 5, 0), slot, c.tid); const unsigned u = u5 & 255u;
        if (u5 >= 256u * QREP) break;
        const int b = u >> 3, h = u & 7; const size_t row0 = (size_t)b * 256;
        att::Src s; s.k0 = Z + row0 * LDZ + ZC_NK + h * 128; s.v0 = Z + row0 * LDZ + ZC_NV + h * 128; s.ldk0 = LDZ; s.ldv0 = LDZ; s.n0 = 4; s.k1 = s.k0; s.v1 = s.v0; s.ldk1 = LDZ; s.ldv1 = LDZ; s.rowclamp = 1 << 20;
        att::attn_unit<1>(Z + row0 * LDZ + ZC_NQ + h * 128, LDZ, OBR + row0 * LDO + 2048 + h * 128, LDO, s, 4, sc_na, na0, qp_na, lds);
    }
    {
        unsigned* cq = (unsigned*)(((unsigned char*)p->ws) + WS_CTL) + 12288 + lq * 16;
        const int nb0 = l == 0 ? (TRI_PER_LAYER - TRI_EARLY + 3) / 4 : 0, nb1 = l + 1 < DEPTH ? (TRI_PER_LAYER - bg_first + 3) / 4 : 0;
        for (;;) {
            const int u = (int)grab(cq, slot, c.tid);
            if (u >= nb0 + nb1) break;
            int t0, te;
            if (u < nb0) { t0 = TRI_EARLY + 4 * u; te = TRI_PER_LAYER; }
            else { t0 = (l + 1) * TRI_PER_LAYER + bg_first + 4 * (u - nb0); te = (l + 2) * TRI_PER_LAYER; }
            prologue_transposes(c, p, t0, 1, t0 + 4 < te ? t0 + 4 : te);
        }
    }
}
constexpr int NPH = 12;
constexpr int N_PHASES = 1 + DEPTH * NPH;
constexpr int LDS_BYTES = LDS_STAGE + 256;
static_assert(att::LDS_END <= LDS_STAGE && 2 * hg::CH_STAGE <= LDS_STAGE, "attention / chain LDS");
#ifndef MK_LAUNCH_MODE
#define MK_LAUNCH_MODE 1
#endif

__global__ void __launch_bounds__(512, 2) mk_fwd(ParamsH p) {
    extern __shared__ __attribute__((aligned(16))) unsigned char lds_raw[];
    Ctx c; c.lds = (LAS unsigned char*)lds_raw; c.tid = threadIdx.x; c.lane = c.tid & 63; c.wid = __builtin_amdgcn_readfirstlane(c.tid >> 6); c.G = gridDim.x; c.bid = blockIdx.x;
    volatile LAS unsigned* bw = (volatile LAS unsigned*)(c.lds + LDS_STAGE);
    if (c.tid < 4) bw[c.tid] = 0u;
    __syncthreads();
    const PkPtr pk = (PkPtr)__builtin_amdgcn_kernarg_segment_ptr();
#define P_ (lp(pk))
    if (p.ph_hi - p.ph_lo > 1) (void)xcd_barrier_post((unsigned*)(((unsigned char*)P_->ws) + WS_CTL), bw);
#ifdef PROBE_THIN2
#define NREP_THIN (P_->ph_hi > 1000 ? 1 : 2)
#else
#define NREP_THIN 1
#endif
#ifdef PROBE_TR2
#define NREP_TR (P_->ph_hi > 1000 ? 1 : 2)
#else
#define NREP_TR 1
#endif
#ifdef PROBE_KPE2
#define NREP_KPE (P_->ph_hi > 1000 ? 1 : 2)
#else
#define NREP_KPE 1
#endif
#ifdef PROBE_G2
#define NREP_G2 (P_->ph_hi > 1000 ? 1 : 2)
#else
#define NREP_G2 1
#endif
#ifdef PROBE_MIX2
#define NREP_MIX (P_->ph_hi > 1000 ? 1 : 2)
#else
#define NREP_MIX 1
#endif
#ifdef PROBE_BAR2
#define SEAM_EXTRA if (P_->ph_hi < 1000) { xcd_barrier(bar_); }
#else
#define SEAM_EXTRA
#endif
#ifndef BG_UP
#define BG_UP 16
#endif
#ifndef BG_KV
#define BG_KV 2
#endif
#ifndef PH_MASK
#define PH_MASK 0xFFFFFFFF
#endif
#define EN(b) ((PH_MASK >> (b)) & 1)
#define IN(k) (P_->ph_lo <= (k) && (k) < P_->ph_hi)
#define SEAM(k) do { if (IN((k) + 1)) { XcdBarrier bar_; bar_.bar = (unsigned*)(((unsigned char*)P_->ws) + WS_CTL); bar_.x = xb_xcc_id(); bar_.st = (volatile LAS unsigned*)(c.lds + LDS_STAGE); xcd_barrier(bar_); SEAM_EXTRA } } while (0)

    if (EN(0) && IN(0)) {
        for (int rr = 0; rr < NREP_THIN; ++rr) {
        for (int r2 = 0; r2 < NREP_TR; ++r2) { prologue_transposes(c, P_, c.bid, c.G, TRI_EARLY); __syncthreads(); }
        prologue_modulation(c, P_); __syncthreads();
        prologue_misc(c, P_); __syncthreads(); }
        SEAM(0);
    }
    const int BG_NUP = ((NTOK / 256) * (FFN2 / 256)) % c.G ? c.G - ((NTOK / 256) * (FFN2 / 256)) % c.G : 0, BG_NKV = ((NKV / 256) * 8) % c.G ? c.G - ((NKV / 256) * 8) % c.G : 0;
    for (int l = 0; l < DEPTH; ++l) {
        const int pb = 1 + l * NPH;
#define wl (((unsigned char*)P_->ws) + WS_WT + (size_t)(l & 1) * WL_BYTES)
#define MODL ((const float*)(((unsigned char*)P_->ws) + WS_MOD) + (size_t)l * 5 * 6 * DM)
#define H ((bf16_t*)(((unsigned char*)P_->ws) + WS_H))
#define Z ((bf16_t*)(((unsigned char*)P_->ws) + WS_Z))
        if (EN(1) && IN(pb + 0)) { for (int rr = 0; rr < NREP_THIN; ++rr) phase_norm(c, P_, l, l == 0, ((const float*)P_->in[I_N1G]) + (size_t)l * DM, 0, 1);
            SEAM(pb + 0); }
        if (EN(2) && IN(pb + 1)) {
            pg8::Gemm g{H, (const bf16_t*)(wl + WL_IN), NTOK, NZ, DM, DM}; pg8::StaticOrder S; S.init(NTOK, NZ, c.G, c.bid);
            pg8::EpiStoreBf16 E{Z, LDZ};
            pg8::gemm_phase(c.lds, g, S, E);
            phase_kpe(c, P_, l);
#ifdef PROBE_GEMM2
            pg8::gemm_phase(c.lds, g, S, E);
#endif
            SEAM(pb + 1);
        }
        if (EN(3) && IN(pb + 2)) { phase_prep_tokens(c, P_, l); __syncthreads(); for (int rr = 0; rr < NREP_THIN; ++rr) { phase_prep_hgrn(c, P_, l); __syncthreads(); } SEAM(pb + 2); }
        if (EN(4) && IN(pb + 3)) {
            pg8::Gemm g{(const bf16_t*)(((unsigned char*)P_->ws) + WS_CKVN), (const bf16_t*)(wl + WL_KV), NKV, 2048, 512, 512}; pg8::StaticOrder S; S.init(NKV, 2048, c.G, c.bid);
            pg8::EpiStoreBf16T<false> E{(bf16_t*)(((unsigned char*)P_->ws) + WS_KVRAW), 2048};
            for (int rr = 0; rr < NREP_G2; ++rr) pg8::gemm_phase(c.lds, g, S, E);
            if (l + 1 < DEPTH && c.bid >= c.G - BG_NKV) { __syncthreads(); prologue_transposes(c, P_, (l + 1) * TRI_PER_LAYER + BG_UP * BG_NUP + (c.bid - (c.G - BG_NKV)), BG_NKV, (l + 1) * TRI_PER_LAYER + BG_UP * BG_NUP + BG_KV * BG_NKV); }
            SEAM(pb + 3);
        }
        if (EN(5) && IN(pb + 4)) { for (int rr = 0; rr < NREP_THIN; ++rr) phase_kfinal(c, P_, l); SEAM(pb + 4); }
        if (EN(6) && IN(pb + 5)) { for (int rr = 0; rr < NREP_MIX; ++rr) phase_mixers(c, P_, l, l + 4 * rr, BG_UP * BG_NUP + BG_KV * BG_NKV); SEAM(pb + 5); }
        if (EN(8) && IN(pb + 6)) {
            pg8::StaticOrder S; S.init(NTOK, DM, c.G, c.bid);
            pg8::Gemm g{(const bf16_t*)(((unsigned char*)P_->ws) + WS_OBR), (const bf16_t*)(wl + WL_BR), NTOK, DM, 3072, LDO}; pg8::EpiGate3 E{Z + ZC_GA, LDZ, H};
            for (int rr = 0; rr < NREP_G2; ++rr) pg8::gemm_phase(c.lds, g, S, E);
            SEAM(pb + 6);
        }
        if (EN(9) && IN(pb + 7)) {
            pg8::Gemm g{H, (const bf16_t*)(wl + WL_OUT), NTOK, DM, DM, DM}; pg8::StaticOrder S; S.init(NTOK, DM, c.G, c.bid);
            pg8::EpiResid E{((const float*)P_->in[I_XP]), ((const float*)P_->in[I_XS]), (bf16_t*)(((unsigned char*)P_->ws) + WS_XB), ((float*)P_->out), MODL + 2 * DM, l == 0 ? 1 : 0, 0};
            pg8::gemm_phase(c.lds, g, S, E);
            SEAM(pb + 7);
        }
        if (EN(10) && IN(pb + 8)) { for (int rr = 0; rr < NREP_THIN; ++rr) phase_norm(c, P_, l, false, ((const float*)P_->in[I_N2G]) + (size_t)l * DM, 3, 4); SEAM(pb + 8); }
        if (EN(11) && IN(pb + 9)) {
            pg8::Gemm g{H, (const bf16_t*)(wl + WL_UP), NTOK, FFN2, DM, DM}; pg8::StaticOrder S; S.init(NTOK, FFN2, c.G, c.bid);
            pg8::EpiConvAct E{(bf16_t*)(((unsigned char*)P_->ws) + WS_ACT), ((const float*)P_->in[I_CONVW]) + (size_t)l * 3 * FFN, ((const float*)P_->in[I_CONVB]) + (size_t)l * FFN, (float*)(((unsigned char*)P_->ws) + WS_EDGE)};
            pg8::gemm_phase(c.lds, g, S, E);
            if (l + 1 < DEPTH && c.bid >= c.G - BG_NUP) { __syncthreads(); prologue_transposes(c, P_, (l + 1) * TRI_PER_LAYER + (c.bid - (c.G - BG_NUP)), BG_NUP, (l + 1) * TRI_PER_LAYER + BG_UP * BG_NUP); }
            SEAM(pb + 9);
        }
        if (EN(12) && IN(pb + 10)) { phase_conv_fix(c, P_, l); SEAM(pb + 10); }
        if (EN(13) && IN(pb + 11)) {
            pg8::Gemm g{(const bf16_t*)(((unsigned char*)P_->ws) + WS_ACT), (const bf16_t*)(wl + WL_DN), NTOK, DM, FFN, FFN}; pg8::StaticOrder S; S.init(NTOK, DM, c.G, c.bid);
            pg8::EpiResid E{((const float*)P_->in[I_XP]), ((const float*)P_->in[I_XS]), (bf16_t*)(((unsigned char*)P_->ws) + WS_XB), ((float*)P_->out), MODL + 5 * DM, 0, l + 1 == DEPTH ? 1 : 0};
            pg8::gemm_phase(c.lds, g, S, E);
            if (l + 1 < DEPTH) SEAM(pb + 11);
        }
    }
#undef IN
#undef SEAM
#undef P_
#undef wl
#undef MODL
#undef H
#undef Z
}

extern "C" void kernel_launch(void* const* d_in, const int* in_sizes, int n_in, void* d_out, int out_size, void* d_ws, size_t ws_size, hipStream_t stream) {
    static int grid = 0;
    if (grid == 0) {
        if (n_in != 30 || (size_t)out_size != O_END || ws_size < WS_END) { fprintf(stderr, "kernel_launch: unexpected shapes (n_in %d out %d ws %zu need %zu)\n", n_in, out_size, ws_size, (size_t)WS_END); grid = -1; return; }
        int dev = 0, cus = 0, per_cu = 0;
        if (hipGetDevice(&dev) != hipSuccess || hipDeviceGetAttribute(&cus, hipDeviceAttributeMultiprocessorCount, dev) != hipSuccess) { grid = -1; return; }
        if (hipFuncSetAttribute((const void*)mk_fwd, hipFuncAttributeMaxDynamicSharedMemorySize, LDS_BYTES) != hipSuccess) { fprintf(stderr, "kernel_launch: hipFuncSetAttribute failed\n"); grid = -1; return; }
        if (hipOccupancyMaxActiveBlocksPerMultiprocessor(&per_cu, (const void*)mk_fwd, 512, LDS_BYTES) != hipSuccess || per_cu < 1) { fprintf(stderr, "kernel_launch: occupancy query says %d\n", per_cu); (void)hipGetLastError(); grid = -1; return; }
        grid = cus;
    }
    if (grid < 0) return;
    (void)hipMemsetAsync((char*)d_ws + WS_CTL, 0, CTL_BYTES, stream);
    ParamsH p{};
    for (int i = 0; i < 30; ++i) p.in[i] = (const float*)d_in[i];
    p.out = (float*)d_out; p.ws = (unsigned char*)d_ws;
#if MK_LAUNCH_MODE == 0
    for (int k = 0; k < N_PHASES; ++k) { p.ph_lo = k; p.ph_hi = k + 1; hipLaunchKernelGGL(mk_fwd, dim3(grid), dim3(512), LDS_BYTES, stream, p); }
#else
    p.ph_lo = 0; p.ph_hi = N_PHASES;
    hipLaunchKernelGGL(mk_fwd, dim3(grid), dim3(512), LDS_BYTES, stream, p);
#endif
    const hipError_t le = hipPeekAtLastError();
    if (le != hipSuccess) fprintf(stderr, "kernel_launch: launch failed: %s\n", hipGetErrorName(le));
}
```

```cpp
#include <hip/hip_runtime.h>
#include <cstdio>
#include <cstdint>

constexpr int DM = 2048;
constexpr int NTC = 8192, NTL = 16384, NTOK = NTC + NTL;
constexpr int NCACHE = 2048;
constexpr int NKV = NTOK + NCACHE;
constexpr int DEPTH = 4;
constexpr int LDZ = 16640;
constexpr int NIN_SRC = 16448;
constexpr int FFN = 5632, FFN2 = 11264;
constexpr int ZC_MQ = 0, ZC_CKV = 1536, ZC_HQ = 2048, ZC_HFF = 3072, ZC_HFB = 4096, ZC_HI = 5120, ZC_HG = 6144,
              ZC_NQ = 7168, ZC_NK = 8192, ZC_NV = 9216, ZC_GA = 10240, ZC_GB = 12288, ZC_GC = 14336;
constexpr int NZ = 16384;
constexpr int ZC_OF = ZC_HQ, ZC_OB = ZC_HFF, ZC_OMLA = ZC_HFB, ZC_ONA = ZC_HI, ZC_OHG = ZC_HG;
constexpr float EPS = 1e-6f;

typedef unsigned short bf16_t;
typedef short bf16x8 __attribute__((ext_vector_type(8)));
typedef short s16x4 __attribute__((ext_vector_type(4)));
typedef float f32x4 __attribute__((ext_vector_type(4)));
typedef float f32x2 __attribute__((ext_vector_type(2)));
typedef float f32x8 __attribute__((ext_vector_type(8)));
typedef float f32x16 __attribute__((ext_vector_type(16)));
typedef unsigned u32x4 __attribute__((ext_vector_type(4)));
typedef unsigned u32x2 __attribute__((ext_vector_type(2)));
typedef __bf16 bfv2 __attribute__((ext_vector_type(2)));

#define DI __device__ __forceinline__
#define LAS __attribute__((address_space(3)))

DI unsigned pk2(float lo, float hi) { f32x2 v = {lo, hi}; bfv2 r = __builtin_convertvector(v, bfv2); return __builtin_bit_cast(unsigned, r); }
DI bf16_t f2bf(float x) { return (bf16_t)(pk2(x, 0.f) & 0xffffu); }
DI float bf2f(bf16_t b) { return __uint_as_float(((unsigned)b) << 16); }
DI float bflo(unsigned w) { return __uint_as_float(w << 16); }
DI float bfhi(unsigned w) { return __uint_as_float(w & 0xffff0000u); }
DI float shfl_xor_l(float v, int o, int lane) { return __builtin_bit_cast(float, __builtin_amdgcn_ds_bpermute((lane ^ o) << 2, __builtin_bit_cast(int, v))); }
DI float wave_sum(float v, int lane) {
#pragma unroll
    for (int o = 32; o >= 1; o >>= 1) v += shfl_xor_l(v, o, lane);
    return v; }
template <int CTRL> DI float dpp_f(float v) { return __builtin_bit_cast(float, __builtin_amdgcn_update_dpp(0, __builtin_bit_cast(int, v), CTRL, 0xF, 0xF, true)); }
DI float group16_sum(float v) { v += dpp_f<0xB1>(v); v += dpp_f<0x4E>(v); v += dpp_f<0x141>(v); v += dpp_f<0x140>(v); return v; }
DI float wave_sum16(float v, int lane) { v = group16_sum(v); v += shfl_xor_l(v, 16, lane); v += shfl_xor_l(v, 32, lane); return v; }
DI void unpack8(const u32x4 w, float (&f)[8]) { f[0] = bflo(w.x); f[1] = bfhi(w.x); f[2] = bflo(w.y); f[3] = bfhi(w.y); f[4] = bflo(w.z); f[5] = bfhi(w.z); f[6] = bflo(w.w); f[7] = bfhi(w.w); }
DI u32x4 pack8f(const float (&f)[8]) { u32x4 w; w.x = pk2(f[0], f[1]); w.y = pk2(f[2], f[3]); w.z = pk2(f[4], f[5]); w.w = pk2(f[6], f[7]); return w; }
DI float sigmoidf_(float x) { return 1.0f / (1.0f + __expf(-x)); }

constexpr size_t al256(size_t x) { return (x + 255) / 256 * 256; }
constexpr size_t WS_CTL = 0;
constexpr size_t CTL_BYTES = 65536;
constexpr size_t WS_MOD = WS_CTL + CTL_BYTES;
constexpr size_t WS_LOWER = WS_MOD + al256((size_t)DEPTH * 5 * 6 * DM * 4);
constexpr size_t WS_ROPE = WS_LOWER + al256(2 * 4 * 1024 * 4);
constexpr size_t WS_WT = WS_ROPE + al256(2 * 64 * 16 * 4);
constexpr size_t WL_IN = 0;
constexpr size_t WL_KV = WL_IN + (size_t)LDZ * DM * 2;
constexpr size_t WL_BR = WL_KV + (size_t)2048 * 512 * 2;
constexpr size_t WL_OUT = WL_BR + (size_t)3 * DM * 1024 * 2;
constexpr size_t WL_UP = WL_OUT + (size_t)DM * DM * 2;
constexpr size_t WL_DN = WL_UP + (size_t)FFN2 * DM * 2;
constexpr size_t WL_KPE = WL_DN + (size_t)DM * FFN * 2;
constexpr size_t WL_BYTES = WL_KPE + (size_t)64 * DM * 2;
constexpr int WT_SLOTS = 2;
constexpr size_t WS_NAKC = WS_WT + (size_t)WT_SLOTS * WL_BYTES;
constexpr size_t WS_NAVC = WS_NAKC + (size_t)DEPTH * 4 * 512 * 1024 * 2;
constexpr size_t WS_H = WS_NAVC + (size_t)DEPTH * 4 * 512 * 1024 * 2;
constexpr size_t WS_Z = WS_H + (size_t)NTOK * DM * 2;
constexpr size_t WS_KVRAW = WS_Z + (size_t)NTOK * LDZ * 2;
constexpr size_t WS_CKVN = WS_KVRAW + (size_t)NKV * 2048 * 2;
constexpr size_t WS_KBUF = WS_CKVN + (size_t)NKV * 512 * 2;
constexpr size_t WS_MACC = WS_KVRAW;
constexpr size_t WS_HG = WS_KBUF + (size_t)NKV * 1536 * 2;
constexpr size_t HG_ARR = (size_t)NTOK * 1024 * 2;
constexpr size_t HG_QTF = 0, HG_KTF = HG_ARR, HG_KTTF = 2 * HG_ARR, HG_QTB = 3 * HG_ARR, HG_KTB = 4 * HG_ARR, HG_KTTB = 5 * HG_ARR, HG_VT = 6 * HG_ARR;
constexpr size_t HG_EV = 7 * HG_ARR;
constexpr size_t HG_BYTES = HG_EV + (size_t)768 * 8 * 2 * 2 * 128 * 4;
constexpr size_t WS_ACT = WS_HG;
constexpr size_t WS_OBR = WS_HG + HG_BYTES;
constexpr int LDO = 3072;
constexpr int LDS_STAGE = 135168;
constexpr int QSLOT_OFF = LDS_STAGE + 64;
constexpr size_t WS_EDGE = WS_KVRAW;
constexpr size_t WS_KPE = WS_OBR + (size_t)NTOK * LDO * 2;
constexpr size_t WS_XB = WS_KPE + (size_t)NTOK * 64 * 2;
constexpr size_t WS_END = WS_XB + (size_t)NTOK * DM * 2;
static_assert((size_t)192 * 2 * 3 * FFN * 4 <= (size_t)NKV * 2048 * 2, "EDGE alias");
static_assert((size_t)NTOK * DM * 4 <= (size_t)NKV * (2048 + 512 + 1536) * 2, "MACC alias");
static_assert((size_t)NTOK * FFN * 2 <= HG_BYTES, "ACT alias");

#define XB_TMO      128
#define XB_XCNT(j)  (256  + 64 * (j))
#define XB_XSUB(j)  (1280 + 64 * (j))
#define XB_XGEN(j)  (2304 + 64 * (j))
#define XB_TOP      3328
#define XB_TOPGEN   3392
#define XCD_BAR_WORDS 3456
#define XB_SPIN_CAP (1u << 23)

DI unsigned xb_ld(unsigned* p)              { return __hip_atomic_load(p, __ATOMIC_RELAXED, __HIP_MEMORY_SCOPE_AGENT); }
DI unsigned xb_add(unsigned* p, unsigned v) { return __hip_atomic_fetch_add(p, v, __ATOMIC_RELAXED, __HIP_MEMORY_SCOPE_AGENT); }
DI unsigned xb_xcc_id() { return (unsigned)__builtin_amdgcn_s_getreg((3 << 11) | 20) & 0xFu; }
#define XB_SPIN(cond, bar) do { unsigned _sp = 0; while (cond) { __builtin_amdgcn_s_sleep(1); \
    if ((++_sp & 255u) == 0u) { if (xb_ld(&(bar)[XB_TMO])) break; if (_sp > XB_SPIN_CAP) { atomicAdd(&(bar)[XB_TMO], 1u); break; } } } } while (0)

struct XcdBarrier { unsigned* bar; unsigned x; volatile LAS unsigned* st; };

DI XcdBarrier xcd_barrier_post(unsigned* bar, volatile LAS unsigned* st) {
    XcdBarrier b; b.bar = bar; b.x = xb_xcc_id(); b.st = st;
    if (threadIdx.x == 0) (void)xb_add(&bar[XB_XCNT(b.x)], 1u);
    return b;
}
DI void xcd_barrier_complete(unsigned* bar, unsigned x, unsigned& nloc, unsigned& nx) {
    const unsigned G = gridDim.x * gridDim.y * gridDim.z;
    unsigned sum, cnt, mine, sp = 0u;
    for (;;) {
        sum = 0u; cnt = 0u; mine = 0u;
#pragma unroll
        for (unsigned j = 0; j < 16; ++j) { const unsigned c = xb_ld(&bar[XB_XCNT(j)]); sum += c; cnt += (c > 0u) ? 1u : 0u; mine = (j == x) ? c : mine; }
        if (sum == G) break;
        __builtin_amdgcn_s_sleep(1);
        if ((++sp & 255u) == 0u) { if (xb_ld(&bar[XB_TMO])) break; if (sp > XB_SPIN_CAP) { atomicAdd(&bar[XB_TMO], 1u); break; } }
    }
    nloc = mine > 0u ? mine : 1u; nx = cnt > 0u ? cnt : 1u;
}
DI void xcd_barrier(const XcdBarrier& b) {
    asm volatile("s_waitcnt vmcnt(0)" ::: "memory");
    __syncthreads();
    if (threadIdx.x == 0) {
        __attribute__((address_space(1))) unsigned* gbar_ = (__attribute__((address_space(1))) unsigned*)b.bar; asm volatile("" : "+v"(gbar_)); unsigned* bar = (unsigned*)gbar_;
        __builtin_amdgcn_s_waitcnt(0);
        unsigned nloc = b.st[0], nx = b.st[1];
        if (nloc == 0u) { xcd_barrier_complete(bar, b.x, nloc, nx); b.st[0] = nloc; b.st[1] = nx; }
        const unsigned old = xb_add(&bar[XB_XSUB(b.x)], 1u);
        const unsigned gen = old / nloc;
        if (old + 1u == (gen + 1u) * nloc) {
            __builtin_amdgcn_fence(__ATOMIC_RELEASE, "agent");
            asm volatile("s_waitcnt vmcnt(0)" ::: "memory");
            const unsigned og = xb_add(&bar[XB_TOP], 1u);
            const unsigned tg = og / nx;
            if (og + 1u == (tg + 1u) * nx) xb_add(&bar[XB_TOPGEN], 1u);
            else XB_SPIN(xb_ld(&bar[XB_TOPGEN]) == tg, bar);
            __builtin_amdgcn_fence(__ATOMIC_ACQUIRE, "agent");
            xb_add(&bar[XB_XGEN(b.x)], 1u);
            asm volatile("s_waitcnt vmcnt(0)" ::: "memory");
        } else {
            XB_SPIN(xb_ld(&bar[XB_XGEN(b.x)]) == gen, bar);
            __builtin_amdgcn_fence(__ATOMIC_ACQUIRE, "agent");
            asm volatile("s_waitcnt vmcnt(0)" ::: "memory");
        }
    }
    __syncthreads();
}
namespace pg8 {
constexpr int BM = 256, BK = 64, HALF = 128, HTB = HALF * BK * 2, STAGE_BYTES = 8 * HTB, NXCD = 8, WGM = 4;

__host__ __device__ __forceinline__ int lds_byte(int r, int c) { const int st = (r >> 4) * 2 + (c >> 5), rr = r & 15, cc = c & 31, ob = rr * 64 + cc * 2; return st * 1024 + (ob ^ (((ob >> 9) & 1) << 5)); }
__host__ __device__ __forceinline__ void stage_rc(int b, int& R, int& C) { const int st = b / 1024, sb = b % 1024, swz = sb ^ (((sb >> 9) & 1) << 5); R = (st >> 1) * 16 + swz / 64; C = (st & 1) * 32 + (swz % 64) / 2; }
__host__ __device__ __forceinline__ int perm32(int rho) { const int n = rho >> 4, i = rho & 15; return 8 * (i >> 2) + 4 * n + (i & 3); }

struct Unit { int pm, pn; };
struct Gemm { const bf16_t* A; const bf16_t* Bt; int M, N, K, lda; };

struct StaticOrder {
    int nM, nN, nwg, G, c;
    __host__ __device__ void init(int M, int N, int G_, int c_) { nM = M / BM; nN = N / BM; nwg = nM * nN; G = G_; c = c_; }
    __host__ __device__ bool next(int i, Unit& u) const {
        const long L = (long)i * G + c; if (L >= nwg) return false;
        int wgid = (int)L; { const int q = nwg / NXCD, r = nwg % NXCD, xcd = wgid % NXCD, off = wgid / NXCD; wgid = (xcd < r ? xcd * (q + 1) : r * (q + 1) + (xcd - r) * q) + off; }
        const int nig = WGM * nN, gid = wgid / nig, fm = gid * WGM, gsz = (nM - fm) < WGM ? (nM - fm) : WGM;
        u.pm = fm + ((wgid % nig) % gsz); u.pn = (wgid % nig) / gsz; return true;
    }
    __device__ __forceinline__ void a_ready(const Unit&) const {}
    __device__ __forceinline__ void done(const Unit&) const {}
};

template <bool NT> struct EpiStoreBf16T {
    static constexpr bool PERM = true; static constexpr int MIDK = 0; static constexpr bool AROWPERM = false; static constexpr bool BJADJ = true;
    bf16_t* O; int ldc;
    __device__ __forceinline__ void operator()(const f32x4 (&acc)[2][2][4][2], const Unit& u, int wr, int wc, int fr, int fq) const {
        const int row0 = u.pm * BM + wr * 64 + fr, col0 = u.pn * BM + wc * 64 + 8 * fq;
#pragma unroll
        for (int ai = 0; ai < 2; ++ai)
#pragma unroll
            for (int m = 0; m < 4; ++m) { bf16_t* rowp = O + (size_t)(row0 + ai * HALF + m * 16) * ldc + col0;
#pragma unroll
                for (int bj = 0; bj < 2; ++bj) { const f32x4 v0 = acc[ai][bj][m][0], v1 = acc[ai][bj][m][1];
                    u32x4 w; w.x = pk2(v0[0], v0[1]); w.y = pk2(v0[2], v0[3]); w.z = pk2(v1[0], v1[1]); w.w = pk2(v1[2], v1[3]);
                    if (NT) __builtin_nontemporal_store(w, (u32x4*)(rowp + bj * 32)); else *(u32x4*)(rowp + bj * 32) = w; } }
    }
};
typedef EpiStoreBf16T<true> EpiStoreBf16;
struct EpiGate3 {
    static constexpr bool PERM = true; static constexpr int MIDK = 16; static constexpr bool AROWPERM = false; static constexpr bool BJADJ = false;
    const bf16_t* gate; int ldg;
    bf16_t* mout;
    static __device__ __forceinline__ float ratio(float a, float b) { return (1.0f + __expf(-b)) * __builtin_amdgcn_rcpf(1.0f + __expf(-a)); }
    __device__ __forceinline__ void mid(f32x4 (&acc)[2][2][4][2], const Unit& u, int seg, int wr, int wc, int fr, int fq) const {
        const int row0 = u.pm * BM + wr * 64 + fr, col0 = u.pn * BM + wc * 32 + 8 * fq;
#pragma unroll
        for (int ai = 0; ai < 2; ++ai) {
            u32x4 ga[4][2], gb[4][2];
#pragma unroll
            for (int m = 0; m < 4; ++m)
#pragma unroll
                for (int bj = 0; bj < 2; ++bj) { const bf16_t* gp = gate + (size_t)(row0 + ai * HALF + m * 16) * ldg + col0 + bj * HALF + seg * 2048; ga[m][bj] = *(const u32x4*)gp; gb[m][bj] = *(const u32x4*)(gp + 2048); }
#pragma unroll
            for (int m = 0; m < 4; ++m)
#pragma unroll
                for (int bj = 0; bj < 2; ++bj) { const u32x4 a = ga[m][bj], b = gb[m][bj];
                    f32x4& v0 = acc[ai][bj][m][0]; f32x4& v1 = acc[ai][bj][m][1];
                    v0[0] *= ratio(bflo(a.x), bflo(b.x)); v0[1] *= ratio(bfhi(a.x), bfhi(b.x)); v0[2] *= ratio(bflo(a.y), bflo(b.y)); v0[3] *= ratio(bfhi(a.y), bfhi(b.y));
                    v1[0] *= ratio(bflo(a.z), bflo(b.z)); v1[1] *= ratio(bfhi(a.z), bfhi(b.z)); v1[2] *= ratio(bflo(a.w), bflo(b.w)); v1[3] *= ratio(bfhi(a.w), bfhi(b.w)); }
            asm volatile("" ::: "memory"); }
    }
    __device__ __forceinline__ void operator()(const f32x4 (&acc)[2][2][4][2], const Unit& u, int wr, int wc, int fr, int fq) const {
        const int row0 = u.pm * BM + wr * 64 + fr, col0 = u.pn * BM + wc * 32 + 8 * fq;
#pragma unroll
        for (int ai = 0; ai < 2; ++ai) {
            u32x4 gc[4][2];
#pragma unroll
            for (int m = 0; m < 4; ++m)
#pragma unroll
                for (int bj = 0; bj < 2; ++bj) gc[m][bj] = *(const u32x4*)(gate + (size_t)(row0 + ai * HALF + m * 16) * ldg + col0 + bj * HALF + 4096);
#pragma unroll
            for (int m = 0; m < 4; ++m) { const size_t row = (size_t)(row0 + ai * HALF + m * 16);
#pragma unroll
                for (int bj = 0; bj < 2; ++bj) { const u32x4 g = gc[m][bj];
                    f32x4 v0 = acc[ai][bj][m][0], v1 = acc[ai][bj][m][1];
                    v0[0] *= sigmoidf_(bflo(g.x)); v0[1] *= sigmoidf_(bfhi(g.x)); v0[2] *= sigmoidf_(bflo(g.y)); v0[3] *= sigmoidf_(bfhi(g.y));
                    v1[0] *= sigmoidf_(bflo(g.z)); v1[1] *= sigmoidf_(bfhi(g.z)); v1[2] *= sigmoidf_(bflo(g.w)); v1[3] *= sigmoidf_(bfhi(g.w));
                    u32x4 w; w.x = pk2(v0[0], v0[1]); w.y = pk2(v0[2], v0[3]); w.z = pk2(v1[0], v1[1]); w.w = pk2(v1[2], v1[3]);
                    *(u32x4*)(mout + row * DM + col0 + bj * HALF) = w; } }
            asm volatile("" ::: "memory"); }
    }
};
struct EpiConvAct {
    static constexpr bool PERM = true; static constexpr int MIDK = 0; static constexpr bool AROWPERM = true; static constexpr bool BJADJ = false;
    bf16_t* act; const float* cw; const float* cb; float* edge;
    __device__ __forceinline__ void operator()(const f32x4 (&acc)[2][2][4][2], const Unit& u, int wr, int wc, int fr, int fq) const {
        const int col0 = u.pn * 128 + wc * 32 + 8 * fq;
        const int tok0 = u.pm * BM + 128 * wr + 8 * fr;
        float w0[8], w1[8], w2[8], bs[8];
        { const f32x4 x0 = *(const f32x4*)(cw + col0), x1 = *(const f32x4*)(cw + col0 + 4), y0 = *(const f32x4*)(cw + FFN + col0), y1 = *(const f32x4*)(cw + FFN + col0 + 4);
          const f32x4 z0 = *(const f32x4*)(cw + 2 * FFN + col0), z1 = *(const f32x4*)(cw + 2 * FFN + col0 + 4), b0 = *(const f32x4*)(cb + col0), b1 = *(const f32x4*)(cb + col0 + 4);
#pragma unroll
          for (int j = 0; j < 4; ++j) { w0[j] = x0[j]; w0[4 + j] = x1[j]; w1[j] = y0[j]; w1[4 + j] = y1[j]; w2[j] = z0[j]; w2[4 + j] = z1[j]; bs[j] = b0[j]; bs[4 + j] = b1[j]; } }
        float gprev0[8], gnext7[8];
#pragma unroll
        for (int n = 0; n < 2; ++n)
#pragma unroll
            for (int j = 0; j < 4; ++j) { gprev0[4 * n + j] = dpp_f<0x111>(acc[1][1][3][n][j]); gnext7[4 * n + j] = dpp_f<0x101>(acc[0][1][0][n][j]); }
#pragma unroll
        for (int idx = 0; idx < 8; ++idx) { const int ai = idx >> 2, m = idx & 3;
            float y[8], o[8];
#pragma unroll
            for (int n = 0; n < 2; ++n)
#pragma unroll
                for (int j = 0; j < 4; ++j) { const int e = 4 * n + j;
                    const float gp = idx > 0 ? acc[(idx - 1) >> 2][1][(idx - 1) & 3][n][j] : gprev0[e];
                    const float gn = idx < 7 ? acc[(idx + 1) >> 2][1][(idx + 1) & 3][n][j] : gnext7[e];
                    y[e] = w0[e] * gp + w1[e] * acc[ai][1][m][n][j] + w2[e] * gn + bs[e];
                    o[e] = y[e] * sigmoidf_(y[e]) * acc[ai][0][m][n][j]; }
            *(u32x4*)(act + (size_t)(tok0 + idx) * FFN + col0) = pack8f(o);
            if ((idx == 0 && fr == 0) || (idx == 7 && fr == 15)) {
                float* e = edge + ((size_t)((u.pm * 2 + wr) * 2 + (idx == 7 ? 1 : 0)) * 3) * FFN + col0;
                *(f32x4*)e = (f32x4){y[0], y[1], y[2], y[3]}; *(f32x4*)(e + 4) = (f32x4){y[4], y[5], y[6], y[7]};
                *(f32x4*)(e + FFN) = acc[ai][0][m][0]; *(f32x4*)(e + FFN + 4) = acc[ai][0][m][1];
                *(f32x4*)(e + 2 * FFN) = acc[ai][1][m][0]; *(f32x4*)(e + 2 * FFN + 4) = acc[ai][1][m][1]; }
        }
    }
};
struct EpiResid {
    static constexpr bool PERM = true; static constexpr int MIDK = 0; static constexpr bool AROWPERM = false; static constexpr bool BJADJ = false;
    const float* xc; const float* xl;
    bf16_t* xb; float* out; const float* gmod;
    int in_f32, out_f32;
    __device__ __forceinline__ void operator()(const f32x4 (&acc)[2][2][4][2], const Unit& u, int wr, int wc, int fr, int fq) const {
        const int row0 = u.pm * BM + wr * 64 + fr, col0 = u.pn * BM + wc * 32 + 8 * fq;
        const int grp = u.pm < 32 ? 0 : 1 + ((u.pm - 32) >> 4);
        const float* gv = gmod + (size_t)grp * (6 * DM);
#define RESID_GATES() f32x4 gg[2][2]; _Pragma("unroll") for (int bj = 0; bj < 2; ++bj) { gg[bj][0] = *(const f32x4*)(gv + col0 + bj * HALF); gg[bj][1] = *(const f32x4*)(gv + col0 + bj * HALF + 4); }
#define RESID_OUT(Y0, Y1, RO) do { if (out_f32) { *(f32x4*)(out + (RO)) = (Y0); *(f32x4*)(out + (RO) + 4) = (Y1); } \
        else { u32x4 w_; w_.x = pk2((Y0)[0], (Y0)[1]); w_.y = pk2((Y0)[2], (Y0)[3]); w_.z = pk2((Y1)[0], (Y1)[1]); w_.w = pk2((Y1)[2], (Y1)[3]); *(u32x4*)(xb + (RO)) = w_; } } while (0)
        if (in_f32) {
#pragma unroll
            for (int ai = 0; ai < 2; ++ai)
#pragma unroll
                for (int mh = 0; mh < 2; ++mh) {
                    RESID_GATES();
                    f32x4 xo[2][2][2];
#pragma unroll
                    for (int mm = 0; mm < 2; ++mm) { const int row = row0 + ai * HALF + (2 * mh + mm) * 16;
                        const float* xr = (row < NTC) ? xc + (size_t)row * DM : xl + (size_t)(row - NTC) * DM;
#pragma unroll
                        for (int bj = 0; bj < 2; ++bj) { xo[mm][bj][0] = *(const f32x4*)(xr + col0 + bj * HALF); xo[mm][bj][1] = *(const f32x4*)(xr + col0 + bj * HALF + 4); } }
#pragma unroll
                    for (int mm = 0; mm < 2; ++mm) { const int m = 2 * mh + mm; const size_t ro = (size_t)(row0 + ai * HALF + m * 16) * DM + col0;
#pragma unroll
                        for (int bj = 0; bj < 2; ++bj) { const f32x4 y0 = xo[mm][bj][0] + gg[bj][0] * acc[ai][bj][m][0], y1 = xo[mm][bj][1] + gg[bj][1] * acc[ai][bj][m][1]; RESID_OUT(y0, y1, ro + bj * HALF); } }
                    asm volatile("" ::: "memory"); }
        } else {
#pragma unroll
            for (int ai = 0; ai < 2; ++ai) {
                RESID_GATES();
                u32x4 xw[4][2];
#pragma unroll
                for (int m = 0; m < 4; ++m)
#pragma unroll
                    for (int bj = 0; bj < 2; ++bj) xw[m][bj] = *(const u32x4*)(xb + (size_t)(row0 + ai * HALF + m * 16) * DM + col0 + bj * HALF);
#pragma unroll
                for (int m = 0; m < 4; ++m) { const size_t ro = (size_t)(row0 + ai * HALF + m * 16) * DM + col0;
#pragma unroll
                    for (int bj = 0; bj < 2; ++bj) { const u32x4 w = xw[m][bj];
                        const f32x4 y0 = (f32x4){bflo(w.x), bfhi(w.x), bflo(w.y), bfhi(w.y)} + gg[bj][0] * acc[ai][bj][m][0], y1 = (f32x4){bflo(w.z), bfhi(w.z), bflo(w.w), bfhi(w.w)} + gg[bj][1] * acc[ai][bj][m][1];
                        RESID_OUT(y0, y1, ro + bj * HALF); } }
                asm volatile("" ::: "memory"); }
        }
#undef RESID_OUT
#undef RESID_GATES
    }
};

template <class Epi, class Sched>
__device__ __forceinline__ void gemm_phase(LAS unsigned char* lds, const Gemm g, const Sched& S, const Epi& E) {
    int tid_ = threadIdx.x; asm volatile("" : "+v"(tid_));
    const int tid = tid_, wid = __builtin_amdgcn_readfirstlane(tid >> 6), lane = tid & 63, wr = wid >> 2, wc = wid & 3, fr = lane & 15, fq = lane >> 4;
    const int K = g.K, nt = K / BK, lda = g.lda;
    unsigned voffA[2], voffB[2];
#pragma unroll
    for (int i = 0; i < 2; ++i) { int R, C; stage_rc(tid * 16 + i * 8192, R, C); const int Rb = Epi::BJADJ ? (2 * (R & ~31) + perm32(R & 31)) : Epi::PERM ? ((R & ~31) + perm32(R & 31)) : R;
        const int Ra = Epi::AROWPERM ? (128 * ((R >> 6) & 1) + 8 * (R & 15) + ((R >> 4) & 3)) : R;
        voffA[i] = (unsigned)(Ra * lda + C) * 2u; voffB[i] = (unsigned)(Rb * K + C) * 2u; }
    const size_t kstep = (size_t)(BK * 2);
    const size_t hstepA = (size_t)(Epi::AROWPERM ? 4 : HALF) * lda * 2, hstepB = (size_t)(Epi::BJADJ ? 32 : HALF) * K * 2;
    const size_t tstepA = (size_t)BM * lda * 2, tstepB = (size_t)BM * K * 2;
    const unsigned ldsw = (unsigned)wid * 1024u;
    const int aoff = lds_byte(wr * 64 + fr, fq * 8), boff = lds_byte(wc * 32 + fr, fq * 8);
#define PG8_SA(b, h) (((b) * 2 + (h)) * HTB)
#define PG8_SB(b, h) ((4 + (b) * 2 + (h)) * HTB)
#define PG8_STAGE(bufoff, gbase, voff) do { _Pragma("unroll") for (int _i = 0; _i < 2; ++_i) \
        __builtin_amdgcn_global_load_lds((const unsigned*)((const char*)(gbase) + (voff)[_i]), (LAS unsigned*)(lds + (bufoff) + ldsw + _i * 8192), 16, 0, 0); } while (0)
#define PG8_LDA(dst, b, h) do { _Pragma("unroll") for (int m = 0; m < 4; ++m) _Pragma("unroll") for (int k = 0; k < 2; ++k) dst[m][k] = *(const LAS bf16x8*)(lds + PG8_SA(b, h) + aoff + m * 2048 + k * 1024); } while (0)
#define PG8_LDB(dst, b, h) do { _Pragma("unroll") for (int n = 0; n < 2; ++n) _Pragma("unroll") for (int k = 0; k < 2; ++k) dst[n][k] = *(const LAS bf16x8*)(lds + PG8_SB(b, h) + boff + n * 2048 + k * 1024); } while (0)
#define PG8_MMA(ai, bj, At, Bt) do { __builtin_amdgcn_s_setprio(1); _Pragma("unroll") for (int m = 0; m < 4; ++m) _Pragma("unroll") for (int n = 0; n < 2; ++n) _Pragma("unroll") for (int k = 0; k < 2; ++k) \
        acc[ai][bj][m][n] = __builtin_amdgcn_mfma_f32_16x16x32_bf16(Bt[n][k], At[m][k], acc[ai][bj][m][n], 0, 0, 0); __builtin_amdgcn_s_setprio(0); } while (0)
#define PG8_WAIT_V(n) asm volatile("s_waitcnt vmcnt(" #n ")" ::: "memory")
#define PG8_WAIT_L(n) asm volatile("s_waitcnt lgkmcnt(" #n ")" ::: "memory")
#define PG8_BAR __builtin_amdgcn_s_barrier()
#define PG8_SCHED __builtin_amdgcn_sched_barrier(0)
    Unit cur, nxt; int ui = 0;
    if (!S.next(0, cur)) return;
    f32x4 acc[2][2][4][2];
#pragma unroll
    for (int a = 0; a < 2; ++a)
#pragma unroll
        for (int b = 0; b < 2; ++b)
#pragma unroll
            for (int m = 0; m < 4; ++m)
#pragma unroll
                for (int n = 0; n < 2; ++n) acc[a][b][m][n] = (f32x4){0.f, 0.f, 0.f, 0.f};
    bf16x8 At[4][2], B0[2][2], B1[2][2];
    const char* cA = (const char*)g.A + (size_t)cur.pm * tstepA; const char* cB = (const char*)g.Bt + (size_t)cur.pn * tstepB;
    S.a_ready(cur);
    PG8_STAGE(PG8_SB(0, 0), cB, voffB); PG8_STAGE(PG8_SA(0, 0), cA, voffA); PG8_STAGE(PG8_SB(0, 1), cB + hstepB, voffB); PG8_STAGE(PG8_SA(0, 1), cA + hstepA, voffA);
    if (wr == 1) PG8_BAR;
    PG8_WAIT_V(4); PG8_BAR;
    PG8_STAGE(PG8_SB(1, 0), cB + kstep, voffB); PG8_STAGE(PG8_SA(1, 0), cA + kstep, voffA); PG8_STAGE(PG8_SB(1, 1), cB + hstepB + kstep, voffB);
    PG8_WAIT_V(6); PG8_BAR;
    for (;;) {
        const bool has_next = S.next(ui + 1, nxt);
        const char* nA = has_next ? (const char*)g.A + (size_t)nxt.pm * tstepA : cA; const char* nB = has_next ? (const char*)g.Bt + (size_t)nxt.pn * tstepB : cB;
        for (int t = 0; t < nt; t += 2) {
            const bool last = (t == nt - 2);
            const char* a1 = cA + (size_t)(t + 1) * kstep;
            const char* a2 = last ? nA : cA + (size_t)(t + 2) * kstep; const char* b2 = last ? nB : cB + (size_t)(t + 2) * kstep;
            const char* a3 = a2 + kstep; const char* b3 = b2 + kstep;
            if (last && has_next) S.a_ready(nxt);
            if constexpr (Epi::MIDK > 0) { if (t > 0 && (t % Epi::MIDK) == 0) E.mid(acc, cur, t / Epi::MIDK - 1, wr, wc, fr, fq); }
            PG8_LDB(B0, 0, 0); PG8_SCHED; PG8_LDA(At, 0, 0); PG8_STAGE(PG8_SA(1, 1), a1 + hstepA, voffA);
            PG8_WAIT_L(8); PG8_BAR; PG8_WAIT_L(0); PG8_MMA(0, 0, At, B0); PG8_BAR; PG8_SCHED;
            PG8_LDB(B1, 0, 1); PG8_STAGE(PG8_SB(0, 0), b2, voffB);
            PG8_BAR; PG8_WAIT_L(0); PG8_MMA(0, 1, At, B1); PG8_BAR;
            PG8_LDA(At, 0, 1); PG8_STAGE(PG8_SA(0, 0), a2, voffA);
            PG8_BAR; PG8_WAIT_L(0); PG8_MMA(1, 0, At, B0); PG8_BAR; PG8_SCHED;
            PG8_STAGE(PG8_SB(0, 1), b2 + hstepB, voffB);
            PG8_WAIT_V(6); PG8_BAR; PG8_MMA(1, 1, At, B1); PG8_BAR;
            PG8_LDB(B0, 1, 0); PG8_SCHED; PG8_LDA(At, 1, 0); PG8_STAGE(PG8_SA(0, 1), a2 + hstepA, voffA);
            PG8_WAIT_L(8); PG8_BAR; PG8_WAIT_L(0); PG8_MMA(0, 0, At, B0); PG8_BAR; PG8_SCHED;
            PG8_LDB(B1, 1, 1); PG8_STAGE(PG8_SB(1, 0), b3, voffB);
            PG8_BAR; PG8_WAIT_L(0); PG8_MMA(0, 1, At, B1); PG8_BAR;
            PG8_LDA(At, 1, 1); PG8_STAGE(PG8_SA(1, 0), a3, voffA);
            PG8_BAR; PG8_WAIT_L(0); PG8_MMA(1, 0, At, B0); PG8_BAR; PG8_SCHED;
            PG8_STAGE(PG8_SB(1, 1), b3 + hstepB, voffB);
            PG8_WAIT_V(6); PG8_BAR; PG8_MMA(1, 1, At, B1); PG8_BAR;
        }
        E(acc, cur, wr, wc, fr, fq); S.done(cur);
        if (!has_next) break;
#pragma unroll
        for (int a = 0; a < 2; ++a)
#pragma unroll
            for (int b = 0; b < 2; ++b)
#pragma unroll
                for (int m = 0; m < 4; ++m)
#pragma unroll
                    for (int n = 0; n < 2; ++n) acc[a][b][m][n] = (f32x4){0.f, 0.f, 0.f, 0.f};
        cur = nxt; cA = nA; cB = nB; ++ui;
    }
    PG8_WAIT_V(0);
    if (wr == 0) PG8_BAR;
    PG8_BAR;
#undef PG8_SA
#undef PG8_SB
#undef PG8_STAGE
#undef PG8_LDA
#undef PG8_LDB
#undef PG8_MMA
#undef PG8_WAIT_V
#undef PG8_WAIT_L
#undef PG8_BAR
#undef PG8_SCHED
}
}
typedef __attribute__((address_space(1))) float gf32_t;
typedef __attribute__((address_space(1))) unsigned char gu8_t;
struct ParamsH {
    const float* in[30];
    float* out;
    unsigned char* ws;
    int ph_lo, ph_hi;
};
struct Params {
    const gf32_t* in[30];
    gf32_t* out;
    gu8_t* ws;
    int ph_lo, ph_hi;
};
static_assert(sizeof(ParamsH) == sizeof(Params), "layout");
enum { I_XP = 0, I_XS, I_CCKV, I_CKPE, I_CNAK, I_CNAV, I_SHG, I_C, I_CCTX, I_WMOD, I_BMOD, I_N1G, I_N2G, I_WIN, I_KVG, I_QG, I_KG, I_WUK, I_WUV,
       I_LB, I_HGG, I_NAQG, I_NAKG, I_RPB, I_WBR, I_WOUT, I_WUP, I_CONVW, I_CONVB, I_WDN };
constexpr size_t O_YP = 0, O_YS = (size_t)NTC * DM, O_CKV = (size_t)NTOK * DM, O_KPE = O_CKV + (size_t)32 * 4 * 256 * 512,
                 O_NAK = O_KPE + (size_t)32 * 4 * 256 * 64, O_NAV = O_NAK + (size_t)32 * 4 * 256 * 1024, O_HGS = O_NAV + (size_t)32 * 4 * 256 * 1024,
                 O_END = O_HGS + (size_t)32 * 4 * 2 * 8 * 128 * 128;

struct Ctx {
    LAS unsigned char* lds; int tid, lane, wid, G, bid;
};
typedef const __attribute__((address_space(4))) Params* PkPtr;
DI PkPtr lp(PkPtr q) { asm volatile("" : "+s"(q)); return q; }
DI Ctx launder(const Ctx& c0) { Ctx c = c0; int t = c0.tid; asm volatile("" : "+v"(t)); c.tid = t; c.lane = t & 63; return c; }

constexpr int TRI_PER_LAYER = 256 * 8 + 8 + 2 * 16 * 2 + 3 * 32 * 4 + 32 * 8 + 176 * 8 + 32 * 22;
constexpr int TRI_EARLY = 256 * 8 + 8 + 2 * 16 * 2;
struct TrItem { const float* src; bf16_t* dst; int ldsrc, K; int zero; };
DI void tr_item(PkPtr p, int t, TrItem& it) {
    it.zero = 0;
    const int l = t / TRI_PER_LAYER; int r = t % TRI_PER_LAYER;
    bf16_t* wl = (bf16_t*)(((unsigned char*)p->ws) + WS_WT + (size_t)(l & 1) * WL_BYTES);
    if (r < 256 * 8) { const int nt = r / 8, kt = r % 8, n0 = nt * 64; const int sc = n0 < 2048 ? n0 : n0 + 64;
        it.src = ((const float*)p->in[I_WIN]) + (size_t)l * DM * NIN_SRC + (size_t)(kt * 256) * NIN_SRC + sc; it.ldsrc = NIN_SRC; it.K = DM; it.dst = wl + WL_IN / 2 + (size_t)n0 * DM + kt * 256; return; }
    r -= 256 * 8;
    if (r < 8) { const int kt = r;
        it.src = ((const float*)p->in[I_WIN]) + (size_t)l * DM * NIN_SRC + (size_t)(kt * 256) * NIN_SRC + 2048; it.ldsrc = NIN_SRC; it.K = DM; it.dst = wl + WL_KPE / 2 + kt * 256; return; }
    r -= 8;
    if (r < 64) { const int which = r / 32, q = r % 32, nt = q / 2, kt = q % 2;
        it.src = ((const float*)p->in[which ? I_WUV : I_WUK]) + (size_t)l * 512 * 1024 + (size_t)(kt * 256) * 1024 + nt * 64; it.ldsrc = 1024; it.K = 512; it.dst = wl + WL_KV / 2 + (size_t)(which * 1024 + nt * 64) * 512 + kt * 256; return; }
    r -= 64;
    if (r < 384) { const int i = r / 128, q = r % 128, nt = q / 4, kt = q % 4;
        it.src = ((const float*)p->in[I_WBR]) + ((size_t)l * 3 + i) * 1024 * DM + (size_t)(kt * 256) * DM + nt * 64; it.ldsrc = DM; it.K = 3072; it.dst = wl + WL_BR / 2 + (size_t)(nt * 64) * 3072 + i * 1024 + kt * 256; return; }
    r -= 384;
    if (r < 256) { const int nt = r / 8, kt = r % 8;
        it.src = ((const float*)p->in[I_WOUT]) + (size_t)l * DM * DM + (size_t)(kt * 256) * DM + nt * 64; it.ldsrc = DM; it.K = DM; it.dst = wl + WL_OUT / 2 + (size_t)(nt * 64) * DM + kt * 256; return; }
    r -= 256;
    if (r < 176 * 8) { const int nt = r / 8, kt = r % 8;
        const int half = nt / 88, np = (nt % 88) * 64, drow = 256 * (np / 128) + 128 * half + (np % 128);
        it.src = ((const float*)p->in[I_WUP]) + (size_t)l * DM * FFN2 + (size_t)(kt * 256) * FFN2 + nt * 64; it.ldsrc = FFN2; it.K = DM; it.dst = wl + WL_UP / 2 + (size_t)drow * DM + kt * 256; return; }
    r -= 176 * 8;
    { const int nt = r / 22, kt = r % 22;
        it.src = ((const float*)p->in[I_WDN]) + (size_t)l * FFN * DM + (size_t)(kt * 256) * DM + nt * 64; it.ldsrc = DM; it.K = FFN; it.dst = wl + WL_DN / 2 + (size_t)(nt * 64) * FFN + kt * 256; return; }
}
DI void prologue_transposes(const Ctx& c0, PkPtr p, int t0, int tstep, int t_end) {
    const Ctx c = launder(c0);
    LAS float* T = (LAS float*)c.lds;
    const int tid = c.tid, i = tid >> 4, j = (tid & 15) * 4, nn = tid >> 3, k8 = (tid & 7) * 8;
    f32x4 v[8];
    int t = t0;
    if (t >= t_end) return;
    TrItem cur; tr_item(p, t, cur);
    if (!cur.zero) {
#pragma unroll
        for (int q = 0; q < 8; ++q) v[q] = *(const f32x4*)(cur.src + (size_t)(i + 32 * q) * cur.ldsrc + j);
    }
    for (;;) {
        if (!cur.zero) {
#pragma unroll
            for (int q = 0; q < 8; ++q) { T[(j + 0) * 257 + i + 32 * q] = v[q][0]; T[(j + 1) * 257 + i + 32 * q] = v[q][1]; T[(j + 2) * 257 + i + 32 * q] = v[q][2]; T[(j + 3) * 257 + i + 32 * q] = v[q][3]; }
        }
        __syncthreads();
        const int tn = t + tstep; const bool more = tn < t_end;
        bf16_t* const cdst = cur.dst; const int cK = cur.K, czero = cur.zero;
        if (more) { tr_item(p, tn, cur);
            if (!cur.zero) {
#pragma unroll
                for (int q = 0; q < 8; ++q) v[q] = *(const f32x4*)(cur.src + (size_t)(i + 32 * q) * cur.ldsrc + j);
            } }
#pragma unroll
        for (int q = 0; q < 4; ++q) { u32x4 w = {0u, 0u, 0u, 0u};
            if (!czero) { const LAS float* r = T + nn * 257 + k8 + 64 * q; w.x = pk2(r[0], r[1]); w.y = pk2(r[2], r[3]); w.z = pk2(r[4], r[5]); w.w = pk2(r[6], r[7]); }
            *(u32x4*)(cdst + (size_t)nn * cK + k8 + 64 * q) = w; }
        __syncthreads();
        if (!more) break;
        t = tn;
    }
}

DI void prologue_modulation(const Ctx& c0, PkPtr p) {
    const Ctx c = launder(c0);
    LAS float* SC = (LAS float*)c.lds;
    LAS float* RED = SC + 5 * DM;
    for (int i = c.tid; i < 5 * DM; i += 512) { const int g = i / DM, k = i % DM; const float x = g == 0 ? ((const float*)p->in[I_CCTX])[k] : ((const float*)p->in[I_C])[(g - 1) * DM + k]; SC[i] = x * sigmoidf_(x); }
    __syncthreads();
    float* MOD = (float*)(((unsigned char*)p->ws) + WS_MOD);
    const int c4 = (c.tid & 15) * 4, ks = c.tid >> 4;
    for (int u = c.bid; u < DEPTH * 192; u += c.G) {
        const int l = u / 192, n0 = (u % 192) * 64;
        const float* w = ((const float*)p->in[I_WMOD]) + (size_t)l * DM * (6 * DM) + n0 + c4;
        f32x4 a0 = {0.f, 0.f, 0.f, 0.f}, a1 = a0, a2 = a0, a3 = a0, a4 = a0;
#pragma unroll 8
        for (int k = ks * 64; k < ks * 64 + 64; ++k) { const f32x4 wv = *(const f32x4*)(w + (size_t)k * (6 * DM));
            a0 += wv * SC[k]; a1 += wv * SC[DM + k]; a2 += wv * SC[2 * DM + k]; a3 += wv * SC[3 * DM + k]; a4 += wv * SC[4 * DM + k]; }
        *(LAS f32x4*)(RED + (ks * 5 + 0) * 64 + c4) = a0; *(LAS f32x4*)(RED + (ks * 5 + 1) * 64 + c4) = a1; *(LAS f32x4*)(RED + (ks * 5 + 2) * 64 + c4) = a2;
        *(LAS f32x4*)(RED + (ks * 5 + 3) * 64 + c4) = a3; *(LAS f32x4*)(RED + (ks * 5 + 4) * 64 + c4) = a4;
        __syncthreads();
        if (c.tid < 320) { const int g = c.tid >> 6, col = c.tid & 63; float s = ((const float*)p->in[I_BMOD])[(size_t)l * (6 * DM) + n0 + col];
#pragma unroll
            for (int q = 0; q < 32; ++q) s += RED[(q * 5 + g) * 64 + col];
            MOD[((size_t)l * 5 + g) * (6 * DM) + n0 + col] = s; }
        __syncthreads();
    }
}

DI void prologue_misc(const Ctx& c0, PkPtr p) {
    const Ctx c = launder(c0);
    float* LOW = (float*)(((unsigned char*)p->ws) + WS_LOWER);
    const int gt = c.bid * 512 + c.tid, GT = c.G * 512;
    for (int i = gt; i < 2 * 1024; i += GT) { const int d = i >> 10, ch = i & 1023; const float* s = ((const float*)p->in[I_LB]) + (size_t)d * 4 * 1024 + ch;
        const float x0 = s[0], x1 = s[1024], x2 = s[2048], x3 = s[3072]; const float mx = fmaxf(fmaxf(x0, x1), fmaxf(x2, x3));
        const float e0 = expf(x0 - mx), e1 = expf(x1 - mx), e2 = expf(x2 - mx), e3 = expf(x3 - mx); const float inv = 1.0f / (e0 + e1 + e2 + e3);
        float* o = LOW + (size_t)d * 4 * 1024 + ch; o[0] = 0.f; o[1024] = e1 * inv; o[2048] = (e1 + e2) * inv; o[3072] = (e1 + e2 + e3) * inv; }
    float* RT = (float*)(((unsigned char*)p->ws) + WS_ROPE);
    for (int i = gt; i < 1024; i += GT) { const int pos = i >> 4, f = i & 15; const float inv = powf(10000.0f, -(float)f / 16.0f); const float a = (float)pos * inv;
        RT[i] = cosf(a); RT[1024 + i] = sinf(a); }
    bf16_t* kc = (bf16_t*)(((unsigned char*)p->ws) + WS_NAKC); bf16_t* vc = (bf16_t*)(((unsigned char*)p->ws) + WS_NAVC);
    const size_t n8 = (size_t)4 * 4 * 512 * 1024 / 8;
    for (size_t i = gt; i < 2 * n8; i += GT) { const bool isv = i >= n8; const size_t j = isv ? i - n8 : i; const size_t e = j * 8;
        const size_t b = e / ((size_t)4 * 512 * 1024), rem = e % ((size_t)4 * 512 * 1024), l = rem / ((size_t)512 * 1024), r2 = rem % ((size_t)512 * 1024);
        const float* s = ((const float*)p->in[isv ? I_CNAV : I_CNAK]) + e; const f32x4 a = *(const f32x4*)s, bq = *(const f32x4*)(s + 4);
        u32x4 w; w.x = pk2(a[0], a[1]); w.y = pk2(a[2], a[3]); w.z = pk2(bq[0], bq[1]); w.w = pk2(bq[2], bq[3]);
        *(u32x4*)((isv ? vc : kc) + (l * 4 + b) * ((size_t)512 * 1024) + r2) = w; }
}

DI int row_group(int row) { return row < NTC ? 0 : 1 + ((row - NTC) >> 12); }

DI void phase_norm(const Ctx& c0, PkPtr p, int l, bool first, const float* gain, int ish, int isc) {
    const Ctx c = launder(c0);
    const float* MOD = (const float*)(((unsigned char*)p->ws) + WS_MOD) + (size_t)l * 5 * 6 * DM;
    bf16_t* H = (bf16_t*)(((unsigned char*)p->ws) + WS_H); const bf16_t* XB = (const bf16_t*)(((unsigned char*)p->ws) + WS_XB);
    const int nw = c.G * 8, per = (NTOK + nw - 1) / nw, r0 = (c.bid * 8 + c.wid) * per, r1 = r0 + per < NTOK ? r0 + per : NTOK;
    if (r0 >= r1) return;
    float v[4][8], av[4][8], sv[4][8]; f32x4 nf[4][2]; u32x4 nb[4]; int cur = -1;
#define NORM_LOAD(row) do { if (first) { const float* x_ = (row) < NTC ? ((const float*)p->in[I_XP]) + (size_t)(row) * DM : ((const float*)p->in[I_XS]) + (size_t)((row) - NTC) * DM; \
        _Pragma("unroll") for (int i = 0; i < 4; ++i) { nf[i][0] = *(const f32x4*)(x_ + i * 512 + c.lane * 8); nf[i][1] = *(const f32x4*)(x_ + i * 512 + c.lane * 8 + 4); } } \
    else { _Pragma("unroll") for (int i = 0; i < 4; ++i) nb[i] = *(const u32x4*)(XB + (size_t)(row) * DM + i * 512 + c.lane * 8); } } while (0)
    NORM_LOAD(r0);
    for (int row = r0; row < r1; ++row) {
        if (first) {
#pragma unroll
            for (int i = 0; i < 4; ++i)
#pragma unroll
                for (int j = 0; j < 4; ++j) { v[i][j] = nf[i][0][j]; v[i][4 + j] = nf[i][1][j]; }
        } else {
#pragma unroll
            for (int i = 0; i < 4; ++i) unpack8(nb[i], v[i]);
        }
        if (row + 1 < r1) NORM_LOAD(row + 1);
        const int grp = row_group(row);
        if (grp != cur) { cur = grp; const float* mg = MOD + (size_t)grp * 6 * DM;
#pragma unroll
            for (int i = 0; i < 4; ++i)
#pragma unroll
                for (int h2 = 0; h2 < 2; ++h2) { const int col = i * 512 + c.lane * 8 + 4 * h2;
                    const f32x4 a = *(const f32x4*)(gain + col) * (*(const f32x4*)(mg + isc * DM + col) + 1.0f), sft = *(const f32x4*)(mg + ish * DM + col);
#pragma unroll
                    for (int j = 0; j < 4; ++j) { av[i][4 * h2 + j] = a[j]; sv[i][4 * h2 + j] = sft[j]; } } }
        float ss = 0.f;
#pragma unroll
        for (int i = 0; i < 4; ++i)
#pragma unroll
            for (int j = 0; j < 8; ++j) ss += v[i][j] * v[i][j];
        ss = wave_sum(ss, c.lane);
        const float rinv = rsqrtf(ss * (1.0f / DM) + EPS);
#pragma unroll
        for (int i = 0; i < 4; ++i) { float y[8];
#pragma unroll
            for (int j = 0; j < 8; ++j) y[j] = v[i][j] * rinv * av[i][j] + sv[i][j];
            *(u32x4*)(H + (size_t)row * DM + i * 512 + c.lane * 8) = pack8f(y); }
    }
#undef NORM_LOAD
}

DI void phase_kpe(const Ctx& c0, PkPtr p, int l) {
    const Ctx c = launder(c0);
    const int lane = c.lane, r = lane & 31, hh = lane >> 5, ch = (c.bid >> 3) & 1, pairi = (c.bid & 7) + 8 * (c.bid >> 4);
    const bf16_t* Bg = (const bf16_t*)(((unsigned char*)p->ws) + WS_WT + (size_t)(l & 1) * WL_BYTES + WL_KPE) + (size_t)(ch * 32) * DM;
#pragma unroll
    for (int i = 0; i < 16; ++i) { const int sl = c.tid + 512 * i, row = sl >> 8, cchunk = (sl & 255) ^ (row & 15);
        __builtin_amdgcn_global_load_lds((const unsigned*)(Bg + (size_t)row * DM + cchunk * 8), (LAS unsigned*)(c.lds + (unsigned)(c.wid * 64 + 512 * i) * 16u), 16, 0, 0); }
    const int rbk = pairi * 6 + c.wid;
    const bool act = c.wid < 6 && rbk < NTOK / 32;
    const bf16_t* A = (const bf16_t*)(((unsigned char*)p->ws) + WS_H) + (size_t)((act ? rbk : 0) * 32 + r) * DM + 8 * hh;
    bf16x8 a[32];
    if (act) {
#pragma unroll
        for (int q = 0; q < 32; ++q) a[q] = *(const bf16x8*)(A + 16 * q);
    }
    asm volatile("s_waitcnt vmcnt(0)" ::: "memory"); __syncthreads();
    if (act) {
        f32x16 acc = f32x16{};
        const LAS char* brow = (const LAS char*)(c.lds + r * 4096);
        for (int k0 = 0; k0 < DM; k0 += 512) {
            bf16x8 an[32];
            if (k0 + 512 < DM) {
#pragma unroll
                for (int q = 0; q < 32; ++q) an[q] = *(const bf16x8*)(A + k0 + 512 + 16 * q);
            }
#pragma unroll
            for (int q = 0; q < 32; ++q) { const int chunk = (k0 >> 3) + 2 * q + hh;
                const bf16x8 bq = *(const LAS bf16x8*)(brow + ((chunk ^ (r & 15)) << 4));
                acc = __builtin_amdgcn_mfma_f32_32x32x16_bf16(a[q], bq, acc, 0, 0, 0); }
            if (k0 + 512 < DM) {
#pragma unroll
                for (int q = 0; q < 32; ++q) a[q] = an[q];
            }
        }
        bf16_t* O = (bf16_t*)(((unsigned char*)p->ws) + WS_KPE) + (size_t)(rbk * 32) * 64 + ch * 32;
#pragma unroll
        for (int i = 0; i < 16; ++i) { const int row = (i & 3) + 8 * (i >> 2) + 4 * hh; O[(size_t)row * 64 + r] = f2bf(acc[i]); }
    }
    __syncthreads();
}

DI void phase_prep_tokens(const Ctx& c0, PkPtr p, int l) {
    const Ctx c = launder(c0);
    bf16_t* Z = (bf16_t*)(((unsigned char*)p->ws) + WS_Z); bf16_t* CK = (bf16_t*)(((unsigned char*)p->ws) + WS_CKVN);
    const float* RT = (const float*)(((unsigned char*)p->ws) + WS_ROPE);
    const float* gq = ((const float*)p->in[I_QG]) + l * 192; const float* gkv = ((const float*)p->in[I_KVG]) + l * 512; const float* gnq = ((const float*)p->in[I_NAQG]) + l * 128; const float* gnk = ((const float*)p->in[I_NAKG]) + l * 128;
    float* out = (float*)p->out;
    const int lane = c.lane, g = lane >> 4, li = lane & 15;
    const bool qact = li < 12;
    float gqv[16], gkvv[8], gnqv[8], gnkv[8];
#pragma unroll
    for (int j = 0; j < 16; ++j) gqv[j] = qact ? gq[16 * li + j] : 0.f;
#pragma unroll
    for (int j = 0; j < 8; ++j) { gkvv[j] = gkv[8 * lane + j]; gnqv[j] = gnq[8 * li + j]; gnkv[j] = gnk[8 * li + j]; }
    for (int row = c.bid * 8 + c.wid; row < NTOK + NCACHE; row += c.G * 8) {
        if (row >= NTOK) {
            const int cr = row - NTOK, b = cr >> 9, pp = cr & 511;
            const float* s = ((const float*)p->in[I_CCKV]) + (((size_t)b * 4 + l) * 512 + pp) * 512 + lane * 8;
            const f32x4 a = *(const f32x4*)s, bq = *(const f32x4*)(s + 4);
            u32x4 w; w.x = pk2(a[0], a[1]); w.y = pk2(a[2], a[3]); w.z = pk2(bq[0], bq[1]); w.w = pk2(bq[2], bq[3]);
            *(u32x4*)(CK + (size_t)row * 512 + lane * 8) = w;
            continue;
        }
        bf16_t* zr = Z + (size_t)row * LDZ;
        const bool lat = row >= NTC;
        const int t = (row - NTC) & 4095, grow = t >> 6, gcol = t & 63;
        const int bb = row >> 8, ss_ = row & 255;
        const size_t obase = ((size_t)bb * 4 + l) * 256 + ss_;
        u32x4 qw[2][2], ckw, nqw[2], nkw[2], nvw[2]; bf16_t kpev = 0;
#pragma unroll
        for (int pass = 0; pass < 2; ++pass) { const bf16_t* q = zr + ZC_MQ + (4 * pass + g) * 192 + 16 * li;
            qw[pass][0] = (u32x4){0u, 0u, 0u, 0u}; qw[pass][1] = qw[pass][0];
            if (qact) { qw[pass][0] = *(const u32x4*)q; qw[pass][1] = *(const u32x4*)(q + 8); }
            nqw[pass] = *(const u32x4*)(zr + ZC_NQ + (4 * pass + g) * 128 + 8 * li); nkw[pass] = *(const u32x4*)(zr + ZC_NK + (4 * pass + g) * 128 + 8 * li);
            nvw[pass] = (u32x4){0u, 0u, 0u, 0u}; if (!lat) nvw[pass] = *(const u32x4*)(zr + ZC_NV + (4 * pass + g) * 128 + 8 * li); }
        ckw = *(const u32x4*)(zr + ZC_CKV + 8 * lane);
        if (!lat) kpev = ((const bf16_t*)(((unsigned char*)p->ws) + WS_KPE))[(size_t)row * 64 + lane];
        { float e[8]; unpack8(ckw, e); float s = 0.f;
#pragma unroll
            for (int j = 0; j < 8; ++j) s += e[j] * e[j];
            s = wave_sum16(s, lane); const float ri = rsqrtf(s * (1.0f / 512.0f) + EPS);
#pragma unroll
            for (int j = 0; j < 8; ++j) e[j] = e[j] * ri * gkvv[j];
            *(u32x4*)(CK + (size_t)row * 512 + 8 * lane) = pack8f(e);
            if (!lat) { float* o = out + O_CKV + obase * 512 + 8 * lane; *(f32x4*)o = (f32x4){e[0], e[1], e[2], e[3]}; *(f32x4*)(o + 4) = (f32x4){e[4], e[5], e[6], e[7]}; } }
        if (!lat) out[O_KPE + obase * 64 + lane] = bf2f(kpev);
#pragma unroll
        for (int pass = 0; pass < 2; ++pass) { const int h = 4 * pass + g;
            { bf16_t* k = zr + ZC_NK + h * 128 + 8 * li; float e[8]; unpack8(nkw[pass], e); float s = 0.f;
#pragma unroll
              for (int j = 0; j < 8; ++j) s += e[j] * e[j];
              s = group16_sum(s); const float ri = rsqrtf(s * (1.0f / 128.0f) + EPS);
#pragma unroll
              for (int j = 0; j < 8; ++j) e[j] = e[j] * ri * gnkv[j];
              *(u32x4*)k = pack8f(e);
              if (!lat) { float* o = out + O_NAK + (obase * 8 + h) * 128 + 8 * li; *(f32x4*)o = (f32x4){e[0], e[1], e[2], e[3]}; *(f32x4*)(o + 4) = (f32x4){e[4], e[5], e[6], e[7]};
                  float v[8]; unpack8(nvw[pass], v);
                  float* ov = out + O_NAV + (obase * 8 + h) * 128 + 8 * li; *(f32x4*)ov = (f32x4){v[0], v[1], v[2], v[3]}; *(f32x4*)(ov + 4) = (f32x4){v[4], v[5], v[6], v[7]}; } }
        }
    }
}

DI int ev_perm(int k) { const int kb = k >> 5, kr = k & 31; return kb * 32 + ((kr >> 2) & 1) * 16 + (kr & 3) + 4 * (kr >> 3); }
DI float clampe(float x) { return fminf(fmaxf(x, -50.f), 50.f); }

DI void phase_prep_hgrn(const Ctx& c0, PkPtr p, int l) {
    const Ctx c = launder(c0);
    const bf16_t* Z = (const bf16_t*)(((unsigned char*)p->ws) + WS_Z);
    unsigned char* HG = ((unsigned char*)p->ws) + WS_HG;
    const float* LOW = (const float*)(((unsigned char*)p->ws) + WS_LOWER);
    const int lane = c.lane, cg = lane & 15, tq = lane >> 4;
    for (int hu = c.bid * 8 + c.wid; hu < 768 * 8 * 2; hu += c.G * 8) {
        const int u = hu >> 1, k0 = 64 * (hu & 1) + 4 * cg;
        const int chunk = u >> 3, h = u & 7;
        const bf16_t* zb = Z + (size_t)(chunk * 32 + 8 * tq) * LDZ + h * 128 + k0;
        bf16_t* VT = (bf16_t*)(HG + HG_VT) + (size_t)u * 4096;
        float* EV = (float*)(HG + HG_EV) + (size_t)u * 512;
        { u32x2 v[8];
#pragma unroll
          for (int i = 0; i < 8; ++i) v[i] = *(const u32x2*)(zb + (size_t)i * LDZ + ZC_HI);
#pragma unroll
          for (int j2 = 0; j2 < 2; ++j2) {
              u32x4 lo, hi;
              lo.x = (v[0][j2] & 0xffffu) | (v[1][j2] << 16); lo.y = (v[2][j2] & 0xffffu) | (v[3][j2] << 16); lo.z = (v[4][j2] & 0xffffu) | (v[5][j2] << 16); lo.w = (v[6][j2] & 0xffffu) | (v[7][j2] << 16);
              hi.x = (v[0][j2] >> 16) | (v[1][j2] & 0xffff0000u); hi.y = (v[2][j2] >> 16) | (v[3][j2] & 0xffff0000u); hi.z = (v[4][j2] >> 16) | (v[5][j2] & 0xffff0000u); hi.w = (v[6][j2] >> 16) | (v[7][j2] & 0xffff0000u);
              *(u32x4*)(VT + (k0 + 2 * j2) * 32 + 8 * tq) = lo; *(u32x4*)(VT + (k0 + 2 * j2 + 1) * 32 + 8 * tq) = hi; } }
        float q[8][4];
#pragma unroll
        for (int i = 0; i < 8; ++i) { const u32x2 w = *(const u32x2*)(zb + (size_t)i * LDZ + ZC_HQ); const float x0 = bflo(w.x), x1 = bfhi(w.x), x2 = bflo(w.y), x3 = bfhi(w.y);
            q[i][0] = x0 * sigmoidf_(x0); q[i][1] = x1 * sigmoidf_(x1); q[i][2] = x2 * sigmoidf_(x2); q[i][3] = x3 * sigmoidf_(x3); }
#pragma unroll
        for (int dir = 0; dir < 2; ++dir) {
            const f32x4 lbv = *(const f32x4*)(LOW + (dir * 4 + l) * 1024 + h * 128 + k0);
            float lf[8][4], kk[8][4];
#pragma unroll
            for (int i = 0; i < 8; ++i) { const u32x2 w = *(const u32x2*)(zb + (size_t)i * LDZ + (dir ? ZC_HFB : ZC_HFF)); const float x[4] = {bflo(w.x), bfhi(w.x), bflo(w.y), bfhi(w.y)};
#pragma unroll
                for (int j = 0; j < 4; ++j) { const float e = __expf(-x[j]), s = 1.0f / (1.0f + e); const float f = lbv[j] + (1.0f - lbv[j]) * s;
                    lf[i][j] = fmaxf(__log2f(f), -100.f); kk[i][j] = (1.0f - lbv[j]) * (e * s); } }
            if (dir == 0) {
#pragma unroll
                for (int i = 1; i < 8; ++i)
#pragma unroll
                    for (int j = 0; j < 4; ++j) lf[i][j] += lf[i - 1][j];
            } else {
#pragma unroll
                for (int i = 6; i >= 0; --i)
#pragma unroll
                    for (int j = 0; j < 4; ++j) lf[i][j] += lf[i + 1][j];
            }
            float off[4], mid[4], last[4];
#pragma unroll
            for (int j = 0; j < 4; ++j) { const float own = dir == 0 ? lf[7][j] : lf[0][j];
                const float x16 = shfl_xor_l(own, 16, lane), x32 = shfl_xor_l(own, 32, lane), x48 = shfl_xor_l(own, 48, lane);
                const float t0 = tq == 0 ? own : tq == 1 ? x16 : tq == 2 ? x32 : x48;
                const float t1 = tq == 1 ? own : tq == 0 ? x16 : tq == 3 ? x32 : x48;
                const float t2 = tq == 2 ? own : tq == 3 ? x16 : tq == 0 ? x32 : x48;
                const float t3 = tq == 3 ? own : tq == 2 ? x16 : tq == 1 ? x32 : x48;
                if (dir == 0) { off[j] = (tq > 0 ? t0 : 0.f) + (tq > 1 ? t1 : 0.f) + (tq > 2 ? t2 : 0.f); mid[j] = t0 + t1; }
                else { off[j] = (tq < 3 ? t3 : 0.f) + (tq < 2 ? t2 : 0.f) + (tq < 1 ? t1 : 0.f); mid[j] = t2 + t3; }
                last[j] = t0 + t1 + t2 + t3; }
            bf16_t* QT = (bf16_t*)(HG + (dir ? HG_QTB : HG_QTF)) + (size_t)u * 4096; bf16_t* KT = (bf16_t*)(HG + (dir ? HG_KTB : HG_KTF)) + (size_t)u * 4096; bf16_t* KTT = (bf16_t*)(HG + (dir ? HG_KTTB : HG_KTTF)) + (size_t)u * 4096;
#pragma unroll
            for (int i = 0; i < 8; ++i) { float qo[4];
#pragma unroll
                for (int j = 0; j < 4; ++j) { const float b_ = lf[i][j] + off[j]; qo[j] = q[i][j] * exp2f(clampe(b_ - mid[j])); kk[i][j] = kk[i][j] * exp2f(clampe(mid[j] - b_)); }
                u32x2 wq; wq.x = pk2(qo[0], qo[1]); wq.y = pk2(qo[2], qo[3]); *(u32x2*)(QT + (8 * tq + i) * 128 + k0) = wq;
                u32x2 wk; wk.x = pk2(kk[i][0], kk[i][1]); wk.y = pk2(kk[i][2], kk[i][3]); *(u32x2*)(KT + (8 * tq + i) * 128 + k0) = wk; }
#pragma unroll
            for (int j = 0; j < 4; ++j) { u32x4 w; w.x = pk2(kk[0][j], kk[1][j]); w.y = pk2(kk[2][j], kk[3][j]); w.z = pk2(kk[4][j], kk[5][j]); w.w = pk2(kk[6][j], kk[7][j]);
                *(u32x4*)(KTT + (k0 + j) * 32 + 8 * tq) = w; }
            if (tq == 0) {
#pragma unroll
                for (int j = 0; j < 4; ++j) { const int pi = ev_perm(k0 + j); EV[dir * 256 + pi] = exp2f(mid[j]); EV[dir * 256 + 128 + pi] = exp2f(last[j] - mid[j]); } }
        }
    }
}

DI void phase_kfinal(const Ctx& c0, PkPtr p, int l) {
    const Ctx c = launder(c0);
    const bf16_t* Z = (const bf16_t*)(((unsigned char*)p->ws) + WS_Z); const bf16_t* KV = (const bf16_t*)(((unsigned char*)p->ws) + WS_KVRAW); bf16_t* KB = (bf16_t*)(((unsigned char*)p->ws) + WS_KBUF);
    const float* RT = (const float*)(((unsigned char*)p->ws) + WS_ROPE);
    const float* gk = ((const float*)p->in[I_KG]) + l * 192; const int lane = c.lane, g = lane >> 4, li = lane & 15;
    float gn[8], gp[4];
#pragma unroll
    for (int j = 0; j < 8; ++j) gn[j] = gk[8 * li + j];
#pragma unroll
    for (int j = 0; j < 4; ++j) gp[j] = gk[128 + 4 * li + j];
    for (int row = c.bid * 8 + c.wid; row < NKV; row += c.G * 8) {
        const bool lat = row >= NTC && row < NTOK;
        float pe[4];
        if (row < NTOK) { const u32x2 w = *(const u32x2*)((const bf16_t*)(((unsigned char*)p->ws) + WS_KPE) + (size_t)row * 64 + 4 * li); pe[0] = bflo(w.x); pe[1] = bfhi(w.x); pe[2] = bflo(w.y); pe[3] = bfhi(w.y); }
        else { const int cr = row - NTOK, b = cr >> 9, pp = cr & 511; const f32x4 w = *(const f32x4*)(((const float*)p->in[I_CKPE]) + (((size_t)b * 4 + l) * 512 + pp) * 64 + 4 * li); pe[0] = w[0]; pe[1] = w[1]; pe[2] = w[2]; pe[3] = w[3]; }
        f32x4 rc = {1.f, 1.f, 1.f, 1.f}, rs = {0.f, 0.f, 0.f, 0.f};
        if (lat) { const int t = (row - NTC) & 4095; const int pos = li < 8 ? (t >> 6) : (t & 63); rc = *(const f32x4*)(RT + pos * 16 + ((4 * li) & 15)); rs = *(const f32x4*)(RT + 1024 + pos * 16 + ((4 * li) & 15)); }
        const float pe2 = group16_sum(pe[0] * pe[0] + pe[1] * pe[1] + pe[2] * pe[2] + pe[3] * pe[3]);
        u32x4 knw[2];
#pragma unroll
        for (int pass = 0; pass < 2; ++pass) knw[pass] = *(const u32x4*)(KV + (size_t)row * 2048 + (4 * pass + g) * 128 + 8 * li);
#pragma unroll
        for (int pass = 0; pass < 2; ++pass) { const int h = 4 * pass + g;
            float e[8]; unpack8(knw[pass], e); float s = 0.f;
#pragma unroll
            for (int j = 0; j < 8; ++j) s += e[j] * e[j];
            s = group16_sum(s) + pe2; const float ri = rsqrtf(s * (1.0f / 192.0f) + EPS);
#pragma unroll
            for (int j = 0; j < 8; ++j) e[j] = e[j] * ri * gn[j];
            float y[4];
#pragma unroll
            for (int j = 0; j < 4; ++j) { float v = pe[j] * ri * gp[j]; const float pr = shfl_xor_l(v, 4, lane);
                y[j] = (li & 4) ? pr * rs[j] + v * rc[j] : v * rc[j] - pr * rs[j]; }
            bf16_t* o = KB + ((size_t)row * 8 + h) * 192;
            *(u32x4*)(o + 8 * li) = pack8f(e);
            u32x2 w; w.x = pk2(y[0], y[1]); w.y = pk2(y[2], y[3]); *(u32x2*)(o + 128 + 4 * li) = w; }
    }
}

DI void phase_hg_combine(const Ctx& c0, PkPtr p, int l) {
    const Ctx c = launder(c0);
    bf16_t* Z = (bf16_t*)(((unsigned char*)p->ws) + WS_Z); bf16_t* OBR = (bf16_t*)(((unsigned char*)p->ws) + WS_OBR); const float* gg = ((const float*)p->in[I_HGG]) + l * 128; const int lane = c.lane, g = lane >> 4, li = lane & 15;
    float gv[8];
#pragma unroll
    for (int j = 0; j < 8; ++j) gv[j] = gg[8 * li + j];
    for (int row = c.bid * 8 + c.wid; row < NTOK; row += c.G * 8) {
        bf16_t* zr = Z + (size_t)row * LDZ;
#pragma unroll
        for (int pass = 0; pass < 2; ++pass) { const int h = 4 * pass + g;
            float a[8], b[8], x[8]; unpack8(*(const u32x4*)(zr + ZC_OF + h * 128 + 8 * li), a); unpack8(*(const u32x4*)(zr + ZC_OB + h * 128 + 8 * li), b); unpack8(*(const u32x4*)(zr + ZC_HG + h * 128 + 8 * li), x);
            float s = 0.f;
#pragma unroll
            for (int j = 0; j < 8; ++j) { a[j] += b[j]; s += a[j] * a[j]; }
            s = group16_sum(s); const float ri = rsqrtf(s * (1.0f / 128.0f) + EPS);
#pragma unroll
            for (int j = 0; j < 8; ++j) a[j] = a[j] * ri * gv[j] * (x[j] * sigmoidf_(x[j]));
            *(u32x4*)(OBR + (size_t)row * LDO + 1024 + h * 128 + 8 * li) = pack8f(a); }
    }
}

DI void phase_conv_fix(const Ctx& c0, PkPtr p, int l) {
    const Ctx c = launder(c0);
    bf16_t* ACT = (bf16_t*)(((unsigned char*)p->ws) + WS_ACT); const float* EDGE = (const float*)(((unsigned char*)p->ws) + WS_EDGE);
    const float* cw = ((const float*)p->in[I_CONVW]) + (size_t)l * 3 * FFN;
    const int nvec = FFN / 4;
    for (int it = c.bid * 512 + c.tid; it < 191 * nvec; it += c.G * 512) {
        const int k = 1 + it / nvec, col = (it % nvec) * 4;
        const int T = 128 * k;
        const bool seqstart = T < NTC ? ((T & 255) == 0) : (((T - NTC) & 4095) == 0);
        if (seqstart) continue;
        const float* eL = EDGE + ((size_t)((k - 1) * 2 + 1) * 3) * FFN + col;
        const float* eF = EDGE + ((size_t)(k * 2 + 0) * 3) * FFN + col;
        const f32x4 yL = *(const f32x4*)eL, aL = *(const f32x4*)(eL + FFN), gL = *(const f32x4*)(eL + 2 * FFN);
        const f32x4 yF = *(const f32x4*)eF, aF = *(const f32x4*)(eF + FFN), gF = *(const f32x4*)(eF + 2 * FFN);
        const f32x4 w0 = *(const f32x4*)(cw + col), w2 = *(const f32x4*)(cw + 2 * FFN + col);
        float oL[4], oF[4];
#pragma unroll
        for (int j = 0; j < 4; ++j) { const float y1 = yL[j] + w2[j] * gF[j]; oL[j] = y1 * sigmoidf_(y1) * aL[j]; const float y2 = yF[j] + w0[j] * gL[j]; oF[j] = y2 * sigmoidf_(y2) * aF[j]; }
        u32x2 wl_; wl_.x = pk2(oL[0], oL[1]); wl_.y = pk2(oL[2], oL[3]); *(u32x2*)(ACT + (size_t)(T - 1) * FFN + col) = wl_;
        u32x2 wf_; wf_.x = pk2(oF[0], oF[1]); wf_.y = pk2(oF[2], oF[3]); *(u32x2*)(ACT + (size_t)T * FFN + col) = wf_;
    }
}
namespace att {
constexpr int NW = 8, QBLK = 32, KVBLK = 64;
constexpr int SHM_V = KVBLK * 128 * 2, SHM_K = KVBLK * 128 * 2, SHM_KR = KVBLK * 64 * 2;
constexpr int OFF_V = 0, OFF_K = 2 * SHM_V, OFF_KR = OFF_K + 2 * SHM_K, OFF_WS = OFF_KR + 2 * SHM_KR, OFF_QR = OFF_WS + NW * 256, OFF_RPB = OFF_QR + NW * 4096, LDS_END = OFF_RPB + 2048;
constexpr float LOG2E = 1.4426950408889634f;
constexpr float THR = 8.f;
#define KSWZ(row, colB) ((row) * 256 + ((colB) ^ (((row) & 7) << 4)))
#define KRSWZ(row, colB) ((row) * 128 + ((colB) ^ (((row) & 7) << 4)))
#define SBAR() __builtin_amdgcn_sched_barrier(0)
DI int crow(int r, int hi) { return (r & 3) + 8 * (r >> 2) + 4 * hi; }

struct Src {
    const bf16_t* k0; const bf16_t* v0; int ldk0, ldv0, n0;
    const bf16_t* k1; const bf16_t* v1; int ldk1, ldv1;
    int rowclamp;
    DI void get(int j, const bf16_t*& kp, const bf16_t*& vp, int& ldk, int& ldv) const {
        if (j < n0) { const int jj = j < rowclamp ? j : rowclamp; kp = k0 + (size_t)jj * 64 * ldk0; vp = v0 + (size_t)jj * 64 * ldv0; ldk = ldk0; ldv = ldv0; }
        else { kp = k1 + (size_t)(j - n0) * 64 * ldk1; vp = v1 + (size_t)(j - n0) * 64 * ldv1; ldk = ldk1; ldv = ldv1; }
    }
};
struct NaInfo { int nloc, lo, qrow; const LAS float* rpb; };
struct QPrep { const float* gain; const float* rope; int tok0; };

DI void partialSM(f32x16& p0, f32x16& p1, float& m_reg, float& mn, float& alpha, const float C, const float thr_raw) {
    float pmax = p0[0];
#pragma unroll
    for (int r = 1; r < 16; ++r) pmax = fmaxf(pmax, p0[r]);
#pragma unroll
    for (int r = 0; r < 16; ++r) pmax = fmaxf(pmax, p1[r]);
    { auto rr = __builtin_amdgcn_permlane32_swap(__float_as_uint(pmax), __float_as_uint(pmax), false, false);
      pmax = fmaxf(__uint_as_float(rr[0]), __uint_as_float(rr[1])); }
    if (__builtin_expect(__all(pmax - m_reg <= thr_raw), 1)) { mn = m_reg; alpha = 1.f; }
    else { mn = fmaxf(m_reg, pmax); alpha = __builtin_amdgcn_exp2f((m_reg - mn) * C); m_reg = mn; }
    const float mnC = -mn * C;
#pragma unroll
    for (int r = 0; r < 16; ++r) p0[r] = fmaf(p0[r], C, mnC);
#pragma unroll
    for (int r = 0; r < 16; ++r) p1[r] = fmaf(p1[r], C, mnC);
#pragma unroll
    for (int r = 0; r < 16; ++r) p0[r] = __builtin_amdgcn_exp2f(p0[r]);
}
DI void finishSM(f32x16& p0, f32x16& p1, float alpha, float& l_reg, bf16x8& pa0, bf16x8& pa1, bf16x8& pa2, bf16x8& pa3) {
#pragma unroll
    for (int r = 0; r < 16; ++r) p1[r] = __builtin_amdgcn_exp2f(p1[r]);
    float ps = 0;
#pragma unroll
    for (int r = 0; r < 16; ++r) ps += p0[r];
#pragma unroll
    for (int r = 0; r < 16; ++r) ps += p1[r];
    { auto rr = __builtin_amdgcn_permlane32_swap(__float_as_uint(ps), __float_as_uint(ps), false, false);
      ps = __uint_as_float(rr[0]) + __uint_as_float(rr[1]); }
    l_reg = l_reg * alpha + ps;
#define PK4(P, BASE, OUT) do { unsigned a0 = pk2(P[BASE + 0], P[BASE + 1]), a1 = pk2(P[BASE + 2], P[BASE + 3]);   \
    unsigned b0 = pk2(P[BASE + 4], P[BASE + 5]), b1 = pk2(P[BASE + 6], P[BASE + 7]);                              \
    auto r0 = __builtin_amdgcn_permlane32_swap(a0, b0, false, false); auto r1 = __builtin_amdgcn_permlane32_swap(a1, b1, false, false); \
    u32x4 w = {r0[0], r1[0], r0[1], r1[1]}; OUT = __builtin_bit_cast(bf16x8, w); } while (0)
    PK4(p0, 0, pa0); PK4(p0, 8, pa1); PK4(p1, 0, pa2); PK4(p1, 8, pa3);
#undef PK4
}
template <int KIND>
DI void qkt(f32x16& p0, f32x16& p1, const char* Ks, const char* Krs, const bf16x8* qr, const LAS char* qrope, int r32, int hi) {
    p0 = f32x16{}; p1 = f32x16{};
#pragma unroll
    for (int d0 = 0; d0 < 8; ++d0) { const int cb = (d0 * 16 + hi * 8) * 2;
        const bf16x8 b0 = *reinterpret_cast<const bf16x8*>(Ks + KSWZ(r32, cb));
        const bf16x8 b1 = *reinterpret_cast<const bf16x8*>(Ks + KSWZ(32 + r32, cb));
        p0 = __builtin_amdgcn_mfma_f32_32x32x16_bf16(b0, qr[d0], p0, 0, 0, 0);
        p1 = __builtin_amdgcn_mfma_f32_32x32x16_bf16(b1, qr[d0], p1, 0, 0, 0); }
    if constexpr (KIND == 0) {
#pragma unroll
        for (int d0 = 0; d0 < 4; ++d0) { const int cb = (d0 * 16 + hi * 8) * 2;
            const bf16x8 b0 = *reinterpret_cast<const bf16x8*>(Krs + KRSWZ(r32, cb));
            const bf16x8 b1 = *reinterpret_cast<const bf16x8*>(Krs + KRSWZ(32 + r32, cb));
            const bf16x8 qq = *reinterpret_cast<const LAS bf16x8*>(qrope + d0 * 1024);
            p0 = __builtin_amdgcn_mfma_f32_32x32x16_bf16(b0, qq, p0, 0, 0, 0);
            p1 = __builtin_amdgcn_mfma_f32_32x32x16_bf16(b1, qq, p1, 0, 0, 0); }
    }
}
DI void na_fix(f32x16& p0, f32x16& p1, int j, const NaInfo& na, const float C, int qc, int hi) {
    const float NEGM = -3.0e38f;
    if (j >= na.nloc) {
        const bool dummy = false;
#pragma unroll
        for (int r = 0; r < 16; ++r) { p0[r] *= C; p1[r] *= C; }
        (void)dummy; return;
    }
    const int kr = na.lo + j, q = na.qrow;
    const int rs = q - 4 < 0 ? 0 : (q - 4 > 56 ? 56 : q - 4);
    const bool rowin = (kr >= rs) && (kr < rs + 8);
    const int dr = kr - q + 7;
    const int cs = qc - 8 < 0 ? 0 : (qc - 8 > 48 ? 48 : qc - 8);
    const LAS float* bt = na.rpb + (rowin ? dr : 0) * 31 + 15;
#pragma unroll
    for (int r = 0; r < 16; ++r) {
        { const int kc = crow(r, hi); int dc = kc - qc; dc = dc < -15 ? -15 : (dc > 15 ? 15 : dc);
          const bool ok = rowin && kc >= cs && kc < cs + 16; p0[r] = ok ? fmaf(p0[r], C, bt[dc]) : NEGM; }
        { const int kc = 32 + crow(r, hi); int dc = kc - qc; dc = dc < -15 ? -15 : (dc > 15 ? 15 : dc);
          const bool ok = rowin && kc >= cs && kc < cs + 16; p1[r] = ok ? fmaf(p1[r], C, bt[dc]) : NEGM; }
    }
}
DI int v_st(int k, int c) { const int kk = (k & ~0xC) | ((k & 4) << 1) | ((k & 8) >> 1); return ((kk >> 3) * 4 + (c >> 5)) * 512 + ((kk & 7) * 32 + (c & 31)) * 2; }
DI int v_rd_base(int lane) { return ((lane & 3) << 3) | (((lane >> 2) & 3) << 6) | (((lane >> 4) & 1) << 5) | (((lane >> 5) & 1) << 8); }
constexpr int v_rd_off(int d0, int ks, int half) { return d0 * 512 + ks * 4096 + half * 2048; }
template <int OFF> DI s16x4 tr_read(int vb) { s16x4 r; asm volatile("ds_read_b64_tr_b16 %0, %1 offset:%2" : "=&v"(r) : "v"(vb), "i"(OFF) : "memory"); return r; }
template <int D0> DI void pv_one(f32x16& od, int vb, bf16x8 pa0, bf16x8 pa1, bf16x8 pa2, bf16x8 pa3) {
    const s16x4 l0 = tr_read<v_rd_off(D0, 0, 0)>(vb), h0 = tr_read<v_rd_off(D0, 0, 1)>(vb), l1 = tr_read<v_rd_off(D0, 1, 0)>(vb), h1 = tr_read<v_rd_off(D0, 1, 1)>(vb);
    const s16x4 l2 = tr_read<v_rd_off(D0, 2, 0)>(vb), h2 = tr_read<v_rd_off(D0, 2, 1)>(vb), l3 = tr_read<v_rd_off(D0, 3, 0)>(vb), h3 = tr_read<v_rd_off(D0, 3, 1)>(vb);
    asm volatile("s_waitcnt lgkmcnt(0)" ::: "memory"); SBAR();
#define PK(L, H) (bf16x8){L[0], L[1], L[2], L[3], H[0], H[1], H[2], H[3]}
    od = __builtin_amdgcn_mfma_f32_32x32x16_bf16(pa0, PK(l0, h0), od, 0, 0, 0);
    od = __builtin_amdgcn_mfma_f32_32x32x16_bf16(pa1, PK(l1, h1), od, 0, 0, 0);
    od = __builtin_amdgcn_mfma_f32_32x32x16_bf16(pa2, PK(l2, h2), od, 0, 0, 0);
    od = __builtin_amdgcn_mfma_f32_32x32x16_bf16(pa3, PK(l3, h3), od, 0, 0, 0);
#undef PK
}
DI void pv_d0(f32x16* o, int vb, bf16x8 pa0, bf16x8 pa1, bf16x8 pa2, bf16x8 pa3) {
    pv_one<0>(o[0], vb, pa0, pa1, pa2, pa3); pv_one<1>(o[1], vb, pa0, pa1, pa2, pa3); pv_one<2>(o[2], vb, pa0, pa1, pa2, pa3); pv_one<3>(o[3], vb, pa0, pa1, pa2, pa3);
}

template <int KIND>
DI void attn_unit(const bf16_t* __restrict__ Qb, int ldq, bf16_t* __restrict__ Ob, int ldo, const Src src, int NT, const float scale, const NaInfo na, const QPrep qp, char* lds) {
    int tid_ = threadIdx.x; asm volatile("" : "+v"(tid_));
    const int tid = tid_, wid = __builtin_amdgcn_readfirstlane(tid >> 6), lane = tid & 63, r32 = lane & 31, hi = lane >> 5;
    char* V_lds = lds + OFF_V; char* K_lds = lds + OFF_K; char* KR_lds = lds + OFF_KR;
    float* ws = (float*)(lds + OFF_WS) + wid * 64; float* li_l = ws; float* al_l = ws + 32;
    const LAS char* qrope = (const LAS char*)(lds + OFF_QR + wid * 4096 + lane * 16);
    const float C = (KIND == 2) ? 1.0f : scale * LOG2E;
    const float CN = scale * LOG2E;
    const float thr_raw = (KIND == 2) ? THR * LOG2E : THR / scale;
    float m_reg = -1e30f, l_reg = 0; f32x16 o[4] = {}; bf16x8 qr[8];
    const bf16_t* Qw = Qb + (size_t)(wid * QBLK + r32) * ldq + hi * 8;
    {
        u32x4 raw[KIND == 0 ? 12 : 8];
#pragma unroll
        for (int d0 = 0; d0 < (KIND == 0 ? 12 : 8); ++d0) raw[d0] = *reinterpret_cast<const u32x4*>(Qw + d0 * 16);
        float ss = 0.f;
#pragma unroll
        for (int d0 = 0; d0 < (KIND == 0 ? 12 : 8); ++d0) { float e[8]; unpack8(raw[d0], e);
#pragma unroll
            for (int j = 0; j < 8; ++j) ss += e[j] * e[j]; }
        { auto rr = __builtin_amdgcn_permlane32_swap(__float_as_uint(ss), __float_as_uint(ss), false, false); ss = __uint_as_float(rr[0]) + __uint_as_float(rr[1]); }
        const float ri = rsqrtf(ss * (KIND == 0 ? (1.0f / 192.0f) : (1.0f / 128.0f)) + EPS);
#pragma unroll
        for (int d0 = 0; d0 < 8; ++d0) { float e[8]; unpack8(raw[d0], e);
            const f32x4 g0 = *(const f32x4*)(qp.gain + d0 * 16 + hi * 8), g1 = *(const f32x4*)(qp.gain + d0 * 16 + hi * 8 + 4);
#pragma unroll
            for (int j = 0; j < 4; ++j) { e[j] = e[j] * ri * g0[j]; e[4 + j] = e[4 + j] * ri * g1[j]; }
            const u32x4 w = pack8f(e); qr[d0] = __builtin_bit_cast(bf16x8, w); }
        if constexpr (KIND == 0) {
            float y[4][8];
#pragma unroll
            for (int d0 = 0; d0 < 4; ++d0) { unpack8(raw[8 + d0], y[d0]);
                const f32x4 g0 = *(const f32x4*)(qp.gain + 128 + d0 * 16 + hi * 8), g1 = *(const f32x4*)(qp.gain + 128 + d0 * 16 + hi * 8 + 4);
#pragma unroll
                for (int j = 0; j < 4; ++j) { y[d0][j] = y[d0][j] * ri * g0[j]; y[d0][4 + j] = y[d0][4 + j] * ri * g1[j]; } }
            if (qp.rope) { const int t = qp.tok0 + wid * QBLK + r32;
#pragma unroll
                for (int pr = 0; pr < 2; ++pr) { const int pos = pr == 0 ? (t >> 6) : (t & 63);
                    const f32x4 c0 = *(const f32x4*)(qp.rope + pos * 16 + hi * 8), c1 = *(const f32x4*)(qp.rope + pos * 16 + hi * 8 + 4);
                    const f32x4 s0 = *(const f32x4*)(qp.rope + 1024 + pos * 16 + hi * 8), s1 = *(const f32x4*)(qp.rope + 1024 + pos * 16 + hi * 8 + 4);
#pragma unroll
                    for (int j = 0; j < 8; ++j) { const float cc = j < 4 ? c0[j & 3] : c1[j & 3], sn = j < 4 ? s0[j & 3] : s1[j & 3];
                        const float x1 = y[2 * pr][j], x2 = y[2 * pr + 1][j];
                        y[2 * pr][j] = x1 * cc - x2 * sn; y[2 * pr + 1][j] = x1 * sn + x2 * cc; } } }
#pragma unroll
            for (int d0 = 0; d0 < 4; ++d0) { const u32x4 w = pack8f(y[d0]); *(LAS u32x4*)(lds + OFF_QR + wid * 4096 + lane * 16 + d0 * 1024) = w; }
        }
    }
    const int qc = (wid & 1) * 32 + r32;
    const int vb0 = (int)(uintptr_t)(LAS char*)(V_lds) + v_rd_base(lane);
    int kofs[2], vrow[2], vcol[2], krofs;
#pragma unroll
    for (int i = 0; i < 2; ++i) { const int sl = tid + 512 * i;
        { const int row = sl >> 4, cch = (sl & 15) ^ (row & 7); kofs[i] = (row << 16) | (cch * 8); }
        { const int sub = sl >> 5, w = sl & 31, kk = (sub >> 2) * 8 + (w >> 2); vrow[i] = (kk & ~0xC) | ((kk & 4) << 1) | ((kk & 8) >> 1); vcol[i] = (sub & 3) * 32 + (w & 3) * 8; } }
    { const int row = tid >> 3, cch = (tid & 7) ^ (row & 7); krofs = (row << 16) | (128 + cch * 8); }
    const unsigned slot0 = (unsigned)wid * 1024u;
#define SDMA(jt, bb) do { const bf16_t *kp_, *vp_; int ldk_, ldv_; src.get((jt), kp_, vp_, ldk_, ldv_); \
    _Pragma("unroll") for (int i_ = 0; i_ < 2; ++i_) { \
        __builtin_amdgcn_global_load_lds((const unsigned*)(kp_ + (size_t)(kofs[i_] >> 16) * ldk_ + (kofs[i_] & 0xffff)), (LAS unsigned*)(K_lds + (bb) * SHM_K + slot0 + i_ * 8192), 16, 0, 0); \
        __builtin_amdgcn_global_load_lds((const unsigned*)(vp_ + (size_t)vrow[i_] * ldv_ + vcol[i_]), (LAS unsigned*)(V_lds + (bb) * SHM_V + slot0 + i_ * 8192), 16, 0, 0); } \
    if constexpr (KIND == 0) __builtin_amdgcn_global_load_lds((const unsigned*)(kp_ + (size_t)(krofs >> 16) * ldk_ + (krofs & 0xffff)), (LAS unsigned*)(KR_lds + (bb) * SHM_KR + slot0), 16, 0, 0); } while (0)
    SDMA(0, 0); asm volatile("s_waitcnt vmcnt(0)" ::: "memory");
#pragma unroll
    for (int d0 = 0; d0 < 8; ++d0) asm volatile("" : "+v"(qr[d0]));
    __syncthreads();
    for (int j = 0; j < NT; ++j) {
        const int b = j & 1;
        f32x16 p0, p1; float mn, al; bf16x8 pa0, pa1, pa2, pa3;
        if (j + 1 < NT) SDMA(j + 1, b ^ 1);
        SBAR();
        bool skip = false;
        if constexpr (KIND == 2) { if (j < na.nloc) { const int kr = na.lo + j, q_ = na.qrow; const int rs_ = q_ - 4 < 0 ? 0 : (q_ - 4 > 56 ? 56 : q_ - 4); skip = !(kr >= rs_ && kr < rs_ + 8); } }
        if (!skip) {
        qkt<KIND>(p0, p1, K_lds + b * SHM_K, KR_lds + b * SHM_KR, qr, qrope, r32, hi);
        if constexpr (KIND == 2) na_fix(p0, p1, j, na, CN, qc, hi);
        partialSM(p0, p1, m_reg, mn, al, C, thr_raw);
        if (__any(al < 1.f)) { if (hi == 0) al_l[r32] = al; asm volatile("s_waitcnt lgkmcnt(0)" ::: "memory");
#pragma unroll
            for (int d = 0; d < 4; ++d)
#pragma unroll
                for (int r = 0; r < 16; ++r) o[d][r] *= al_l[crow(r, hi)]; }
        finishSM(p0, p1, al, l_reg, pa0, pa1, pa2, pa3); SBAR();
        pv_d0(o, vb0 + b * SHM_V, pa0, pa1, pa2, pa3);
        }
        asm volatile("s_waitcnt vmcnt(0)" ::: "memory");
        __syncthreads();
    }
    if (hi == 0) li_l[r32] = l_reg; asm volatile("s_waitcnt lgkmcnt(0)" ::: "memory");
    float rli[16];
#pragma unroll
    for (int r = 0; r < 16; ++r) rli[r] = __builtin_amdgcn_rcpf(li_l[crow(r, hi)]);
    bf16_t* Ow = Ob + (size_t)(wid * QBLK) * ldo;
#pragma unroll
    for (int r = 0; r < 16; ++r) { const int orow = crow(r, hi);
#pragma unroll
        for (int d0 = 0; d0 < 4; ++d0) Ow[(size_t)orow * ldo + d0 * 32 + r32] = f2bf(o[d0][r] * rli[r]); }
    asm volatile("s_waitcnt vmcnt(0) lgkmcnt(0)" ::: "memory");
    __syncthreads();
#undef SDMA
}
}
namespace hg {
DI int crow(int r, int hi) { return (r & 3) + 8 * (r >> 2) + 4 * hi; }
DI bf16x8 pack8(const f32x16& x, int s) {
    u32x4 w; w.x = pk2(x[8 * s + 0], x[8 * s + 1]); w.y = pk2(x[8 * s + 2], x[8 * s + 3]); w.z = pk2(x[8 * s + 4], x[8 * s + 5]); w.w = pk2(x[8 * s + 6], x[8 * s + 7]);
    return __builtin_bit_cast(bf16x8, w);
}
DI bf16x8 ldperm(const bf16_t* rowp, int kk, int hh) {
    const u32x2 a = *(const u32x2*)(rowp + 16 * kk + 4 * hh), b = *(const u32x2*)(rowp + 16 * kk + 8 + 4 * hh);
    u32x4 w = {a.x, a.y, b.x, b.y}; return __builtin_bit_cast(bf16x8, w);
}
#define HMFMA(a, b, c) __builtin_amdgcn_mfma_f32_32x32x16_bf16((a), (b), (c), 0, 0, 0)

constexpr int CH_QT = 0, CH_KT = 8192, CH_KTT = 16384, CH_VT = 24576, CH_EV = 32768, CH_BYTES = 33792, CH_STAGE = 2 * CH_BYTES;
DI bf16x8 lds_perm16(const LAS char* row, int kk, int hh, int swz) {
    const u32x2 a = *(const LAS u32x2*)(row + (((2 * kk) ^ swz) << 4) + 8 * hh), b = *(const LAS u32x2*)(row + (((2 * kk + 1) ^ swz) << 4) + 8 * hh);
    u32x4 w = {a.x, a.y, b.x, b.y}; return __builtin_bit_cast(bf16x8, w);
}
DI void chain_stage(PkPtr p, LAS unsigned char* sb, int dir, int wv, int lane, size_t u) {
    const unsigned char* HG = (const unsigned char*)p->ws + WS_HG;
    const char* gq = (const char*)(HG + (dir ? HG_QTB : HG_QTF)) + u * 8192;
    const char* gk = (const char*)(HG + (dir ? HG_KTB : HG_KTF)) + u * 8192;
    const char* gt = (const char*)(HG + (dir ? HG_KTTB : HG_KTTF)) + u * 8192;
    const char* gv = (const char*)(HG + HG_VT) + u * 8192;
#pragma unroll
    for (int j = 0; j < 2; ++j) {
        const int pi = wv * 64 + lane + 256 * j;
        const int r16 = pi >> 4, c16 = (pi & 15) ^ (r16 & 15);
        const int r4 = pi >> 2, c4 = (pi & 3) ^ ((r4 >> 2) & 3);
        const unsigned lo = (unsigned)(wv * 64 + 256 * j) * 16u;
        __builtin_amdgcn_global_load_lds((const unsigned*)(gq + r16 * 256 + c16 * 16), (LAS unsigned*)(sb + CH_QT + lo), 16, 0, 0);
        __builtin_amdgcn_global_load_lds((const unsigned*)(gk + r16 * 256 + c16 * 16), (LAS unsigned*)(sb + CH_KT + lo), 16, 0, 0);
        __builtin_amdgcn_global_load_lds((const unsigned*)(gt + r4 * 64 + c4 * 16), (LAS unsigned*)(sb + CH_KTT + lo), 16, 0, 0);
        __builtin_amdgcn_global_load_lds((const unsigned*)(gv + r4 * 64 + c4 * 16), (LAS unsigned*)(sb + CH_VT + lo), 16, 0, 0);
    }
    if (wv == 0) { const char* ge = (const char*)(HG + HG_EV) + u * 2048 + dir * 1024;
        __builtin_amdgcn_global_load_lds((const unsigned*)(ge + lane * 16), (LAS unsigned*)(sb + CH_EV), 16, 0, 0); }
}
DI void chain_unit(PkPtr p, LAS unsigned char* lds, int l, bool lat, int b, int h, int tid_) {
    int tid = tid_; asm volatile("" : "+v"(tid));
    const int lane = tid & 63, wid = __builtin_amdgcn_readfirstlane(tid >> 6), dir = wid >> 2, vs = wid & 3;
    const int r = lane & 31, hh = lane >> 5;
    const int tok0 = lat ? NTC + b * 4096 : b * 256, nch = lat ? 128 : 8;
    bf16_t* Z = (bf16_t*)((unsigned char*)p->ws + WS_Z);
    f32x16 S[4];
    if (lat) { const float* s0 = (const float*)p->in[I_SHG] + ((((size_t)b * 4 + l) * 2 + dir) * 8 + h) * (128 * 128) + 32 * vs + r;
#pragma unroll
        for (int kb = 0; kb < 4; ++kb)
#pragma unroll
            for (int i = 0; i < 16; ++i) S[kb][i] = s0[(size_t)(32 * kb + crow(i, hh)) * 128];
    } else {
#pragma unroll
        for (int kb = 0; kb < 4; ++kb) S[kb] = f32x16{};
    }
    const size_t ubase = (size_t)(tok0 / 32) * 8 + h;
    chain_stage(p, lds + dir * CH_BYTES, dir, vs, lane, ubase + (size_t)(dir ? nch - 1 : 0) * 8);
    asm volatile("s_waitcnt vmcnt(0)" ::: "memory"); __syncthreads();
    for (int cc = 0; cc < nch; ++cc) {
        const int ci = dir ? nch - 1 - cc : cc;
        if (cc + 1 < nch) chain_stage(p, lds + ((cc + 1) & 1) * CH_STAGE + dir * CH_BYTES, dir, vs, lane, ubase + (size_t)(dir ? ci - 1 : ci + 1) * 8);
        const LAS char* sb = (const LAS char*)(lds + (cc & 1) * CH_STAGE + dir * CH_BYTES);
        const LAS float* EV = (const LAS float*)(sb + CH_EV);
        const LAS char* qrow = sb + CH_QT + r * 256; const LAS char* krow = sb + CH_KT + r * 256; const int sw16 = r & 15;
        f32x16 pT = f32x16{}, o = f32x16{};
#pragma unroll
        for (int kb = 0; kb < 4; ++kb) {
            const LAS f32x4* e = (const LAS f32x4*)(EV + kb * 32 + hh * 16);
            const f32x4 e0 = e[0], e1 = e[1], e2 = e[2], e3 = e[3];
            const bf16x8 q0 = lds_perm16(qrow, 2 * kb, hh, sw16), k0 = lds_perm16(krow, 2 * kb, hh, sw16);
            const bf16x8 q1 = lds_perm16(qrow, 2 * kb + 1, hh, sw16), k1 = lds_perm16(krow, 2 * kb + 1, hh, sw16);
#pragma unroll
            for (int i = 0; i < 4; ++i) { S[kb][i] *= e0[i]; S[kb][4 + i] *= e1[i]; S[kb][8 + i] *= e2[i]; S[kb][12 + i] *= e3[i]; }
            const bf16x8 s0 = pack8(S[kb], 0), s1 = pack8(S[kb], 1);
            pT = HMFMA(k0, q0, pT); o = HMFMA(q0, s0, o);
            pT = HMFMA(k1, q1, pT); o = HMFMA(q1, s1, o);
            __builtin_amdgcn_sched_barrier(0);
        }
#pragma unroll
        for (int i = 0; i < 16; ++i) { const int s = crow(i, hh); const bool keep = dir ? (s >= r) : (s <= r); pT[i] = keep ? pT[i] : 0.f; }
        const int vr = 32 * vs + r, swv = (vr >> 2) & 3;
        const LAS char* vrow = sb + CH_VT + vr * 64;
        { const u32x2 a0 = *(const LAS u32x2*)(vrow + ((0 ^ swv) << 4) + 8 * hh), b0 = *(const LAS u32x2*)(vrow + ((1 ^ swv) << 4) + 8 * hh);
          const u32x2 a1 = *(const LAS u32x2*)(vrow + ((2 ^ swv) << 4) + 8 * hh), b1 = *(const LAS u32x2*)(vrow + ((3 ^ swv) << 4) + 8 * hh);
          const u32x4 w0 = {a0.x, a0.y, b0.x, b0.y}, w1 = {a1.x, a1.y, b1.x, b1.y};
          o = HMFMA(pack8(pT, 0), __builtin_bit_cast(bf16x8, w0), o);
          o = HMFMA(pack8(pT, 1), __builtin_bit_cast(bf16x8, w1), o); }
        { bf16_t* op = Z + (size_t)(tok0 + ci * 32) * LDZ + (dir ? ZC_OB : ZC_OF) + h * 128 + 32 * vs + r;
#pragma unroll
            for (int i = 0; i < 16; ++i) op[(size_t)crow(i, hh) * LDZ] = f2bf(o[i]); }
        __builtin_amdgcn_sched_barrier(0);
        const bf16x8 v0 = *(const LAS bf16x8*)(vrow + ((hh ^ swv) << 4)), v1 = *(const LAS bf16x8*)(vrow + (((2 + hh) ^ swv) << 4));
        const int swk = (r >> 2) & 3;
#pragma unroll
        for (int kb = 0; kb < 4; ++kb) {
            const LAS char* trow = sb + CH_KTT + (32 * kb + r) * 64;
            const bf16x8 a0 = *(const LAS bf16x8*)(trow + ((hh ^ swk) << 4)), a1 = *(const LAS bf16x8*)(trow + (((2 + hh) ^ swk) << 4));
            S[kb] = HMFMA(a0, v0, S[kb]); S[kb] = HMFMA(a1, v1, S[kb]);
            const LAS f32x4* e = (const LAS f32x4*)(EV + 128 + kb * 32 + hh * 16);
            const f32x4 e0 = e[0], e1 = e[1], e2 = e[2], e3 = e[3];
#pragma unroll
            for (int i = 0; i < 4; ++i) { S[kb][i] *= e0[i]; S[kb][4 + i] *= e1[i]; S[kb][8 + i] *= e2[i]; S[kb][12 + i] *= e3[i]; }
        }
        asm volatile("s_waitcnt vmcnt(0)" ::: "memory"); __syncthreads();
    }
    if (!lat) { float* so = (float*)p->out + O_HGS + ((((size_t)b * 4 + l) * 2 + dir) * 8 + h) * (128 * 128) + 32 * vs + r;
#pragma unroll
        for (int kb = 0; kb < 4; ++kb)
#pragma unroll
            for (int i = 0; i < 16; ++i) so[(size_t)(32 * kb + crow(i, hh)) * 128] = S[kb][i];
    }
    { bf16_t* OBR = (bf16_t*)((unsigned char*)p->ws + WS_OBR); const float* gg = (const float*)p->in[I_HGG] + l * 128;
      const int g4 = lane >> 4, li = lane & 15;
      float gv[8];
#pragma unroll
      for (int j = 0; j < 8; ++j) gv[j] = gg[8 * li + j];
      for (int rr = wid * 4 + g4; rr < nch * 32; rr += 32) {
          const bf16_t* zr = Z + (size_t)(tok0 + rr) * LDZ + h * 128 + 8 * li;
          float a[8], bb[8], x[8]; unpack8(*(const u32x4*)(zr + ZC_OF), a); unpack8(*(const u32x4*)(zr + ZC_OB), bb); unpack8(*(const u32x4*)(zr + ZC_HG), x);
          float s = 0.f;
#pragma unroll
          for (int j = 0; j < 8; ++j) { a[j] += bb[j]; s += a[j] * a[j]; }
          s = group16_sum(s); const float ri = rsqrtf(s * (1.0f / 128.0f) + EPS);
#pragma unroll
          for (int j = 0; j < 8; ++j) a[j] = a[j] * ri * gv[j] * (x[j] * sigmoidf_(x[j]));
          *(u32x4*)(OBR + (size_t)(tok0 + rr) * LDO + 1024 + h * 128 + 8 * li) = pack8f(a); } }
}
#undef HMFMA
}

DI void load_rpb(const Ctx& c, PkPtr p, int l, int h) {
    LAS float* T = (LAS float*)(c.lds + att::OFF_RPB);
    const float* s = ((const float*)p->in[I_RPB]) + ((size_t)l * 8 + h) * (15 * 31);
    for (int i = c.tid; i < 15 * 31; i += 512) T[i] = s[i] * att::LOG2E;
    __syncthreads();
}

constexpr int QW_BASE = 4096;
DI unsigned* qword(PkPtr p, int l, int cat, int q) { return (unsigned*)(((unsigned char*)p->ws) + WS_CTL) + QW_BASE + ((l * 6 + cat) * 8 + q) * 16; }
DI unsigned grab(unsigned* ctr, volatile LAS unsigned* slot, int tid) {
    __syncthreads();
    if (tid == 0) *slot = __hip_atomic_fetch_add(ctr, 1u, __ATOMIC_RELAXED, __HIP_MEMORY_SCOPE_AGENT);
    __syncthreads();
    return (unsigned)__builtin_amdgcn_readfirstlane((int)*slot);
}
DI unsigned peek8(unsigned* ctr0, unsigned n, volatile LAS unsigned* slot, int tid) {
    __syncthreads();
    if (tid < 64) { const unsigned v = tid < 8 ? __hip_atomic_load(ctr0 + 16 * tid, __ATOMIC_RELAXED, __HIP_MEMORY_SCOPE_AGENT) : n;
        const unsigned long long bm = __ballot(v < n); if (tid == 0) *slot = (unsigned)bm & 0xffu; }
    __syncthreads();
    return (unsigned)__builtin_amdgcn_readfirstlane((int)*slot);
}

#ifdef PROBE_MIXQ2
#define QREP 2u
#else
#define QREP 1u
#endif
#ifdef PROBE_MLAQ2
#define QREP1 2u
#else
#define QREP1 QREP
#endif
DI void phase_mixers(const Ctx& c0, PkPtr p, int l, int lq, int bg_first) {
    const Ctx c = launder(c0);
    bf16_t* Z = (bf16_t*)(((unsigned char*)p->ws) + WS_Z); const bf16_t* KB = (const bf16_t*)(((unsigned char*)p->ws) + WS_KBUF); const bf16_t* KV = (const bf16_t*)(((unsigned char*)p->ws) + WS_KVRAW);
    char* lds = (char*)c.lds; bf16_t* OBR = (bf16_t*)(((unsigned char*)p->ws) + WS_OBR);
    const float sc_mla = 0.07216878364870322f, sc_na = 0.08838834764831845f;
    att::NaInfo na0; na0.nloc = 0; na0.lo = 0; na0.qrow = 0; na0.rpb = (const LAS float*)(c.lds + att::OFF_RPB);
    const float* RT_ = (const float*)(((unsigned char*)p->ws) + WS_ROPE);
    const att::QPrep qp_mla_lat0{((const float*)p->in[I_QG]) + l * 192, RT_, 0}, qp_mla_ctx{((const float*)p->in[I_QG]) + l * 192, nullptr, 0}, qp_na{((const float*)p->in[I_NAQG]) + l * 128, nullptr, 0};
    volatile LAS unsigned* slot = (volatile LAS unsigned*)(c.lds + QSLOT_OFF);
    const int x = (int)(xb_xcc_id() & 7u);
#ifndef MIX_MASK
#define MIX_MASK 31
#endif
    if (MIX_MASK & 16) {
        int q = x;
        for (;;) {
            const unsigned u0 = grab(qword(p, lq, 0, q), slot, c.tid); const unsigned u = u0 & 3u;
            if (u0 < 4u * QREP) { const int v = q * 4 + (int)u; hg::chain_unit(p, c.lds, l, true, v >> 3, v & 7, c.tid); continue; }
            const unsigned m = peek8(qword(p, lq, 0, 0), 4u * QREP, slot, c.tid);
            if (!m) break;
            const unsigned rot = ((m >> x) | (m << (8 - x))) & 0xffu; q = (x + __builtin_ctz(rot)) & 7;
        }
    }
    if (MIX_MASK & 1) {
        int q = x;
        for (;;) {
            const unsigned u1 = grab(qword(p, lq, 1, q), slot, c.tid); const unsigned u = u1 & 63u;
            if (u1 < 64u * QREP1) {
                const int pair = q * 4 + (int)(u >> 4), blk = (int)(u & 15u);
                const int b = pair >> 3, h = pair & 7;
                const size_t qrow0 = (size_t)NTC + b * 4096 + blk * 256;
                att::Src s; s.k0 = KB + ((size_t)(NTC + b * 4096) * 8 + h) * 192; s.v0 = KV + (size_t)(NTC + b * 4096) * 2048 + 1024 + h * 128; s.ldk0 = 1536; s.ldv0 = 2048; s.n0 = 64;
                s.k1 = KB + ((size_t)(NTOK + b * 512) * 8 + h) * 192; s.v1 = KV + (size_t)(NTOK + b * 512) * 2048 + 1024 + h * 128; s.ldk1 = 1536; s.ldv1 = 2048; s.rowclamp = 1 << 20;
                att::QPrep qpl = qp_mla_lat0; qpl.tok0 = blk * 256;
                att::attn_unit<0>(Z + qrow0 * LDZ + ZC_MQ + h * 192, LDZ, OBR + qrow0 * LDO + h * 128, LDO, s, 72, sc_mla, na0, qpl, lds);
                continue;
            }
            const unsigned m = peek8(qword(p, lq, 1, 0), 64u * QREP1, slot, c.tid);
            if (!m) break;
            const unsigned rot = ((m >> x) | (m << (8 - x))) & 0xffu; q = (x + __builtin_ctz(rot)) & 7;
        }
    }
    if (MIX_MASK & 2) for (;;) {
        const unsigned u2 = grab(qword(p, lq, 2, 0), slot, c.tid); const unsigned u = u2 & 511u;
        if (u2 >= 512u * QREP) break;
        const int b = u >> 7, h = (u >> 4) & 7, blk = u & 15;
        load_rpb(c, p, l, h);
        const int r0 = blk * 4;
        const int lo = r0 - 4 < 0 ? 0 : (r0 - 4 > 56 ? 56 : r0 - 4);
        const int r3 = r0 + 3; const int rs3 = r3 - 4 < 0 ? 0 : (r3 - 4 > 56 ? 56 : r3 - 4);
        const int nloc = rs3 + 8 - lo, nlp = (nloc + 1) & ~1;
        const size_t qrow0 = (size_t)NTC + b * 4096 + blk * 256, krow0 = (size_t)NTC + b * 4096 + lo * 64;
        att::Src s; s.k0 = Z + krow0 * LDZ + ZC_NK + h * 128; s.v0 = Z + krow0 * LDZ + ZC_NV + h * 128; s.ldk0 = LDZ; s.ldv0 = LDZ; s.n0 = nlp;
        s.k1 = (const bf16_t*)(((unsigned char*)p->ws) + WS_NAKC) + ((size_t)(l * 4 + b) * 512) * 1024 + h * 128; s.v1 = (const bf16_t*)(((unsigned char*)p->ws) + WS_NAVC) + ((size_t)(l * 4 + b) * 512) * 1024 + h * 128; s.ldk1 = 1024; s.ldv1 = 1024;
        s.rowclamp = 63 - lo;
        att::NaInfo na; na.nloc = nlp; na.lo = lo; na.qrow = r0 + (c.wid >> 1); na.rpb = na0.rpb;
        att::attn_unit<2>(Z + qrow0 * LDZ + ZC_NQ + h * 128, LDZ, OBR + qrow0 * LDO + 2048 + h * 128, LDO, s, nlp + 8, sc_na, na, qp_na, lds);
    }
    if (MIX_MASK & 16) for (;;) {
        const unsigned u3 = grab(qword(p, lq, 3, 0), slot, c.tid); const unsigned u = u3 & 255u;
        if (u3 >= 256u * QREP) break;
        hg::chain_unit(p, c.lds, l, false, (int)(u >> 3), (int)(u & 7u), c.tid);
    }
    if (MIX_MASK & 4) for (;;) {
        const unsigned u4 = grab(qword(p, lq, 4, 0), slot, c.tid); const unsigned u = u4 & 255u;
        if (u4 >= 256u * QREP) break;
        const int b = u >> 3, h = u & 7; const size_t row0 = (size_t)b * 256;
        att::Src s; s.k0 = KB + (row0 * 8 + h) * 192; s.v0 = KV + row0 * 2048 + 1024 + h * 128; s.ldk0 = 1536; s.ldv0 = 2048; s.n0 = 4; s.k1 = s.k0; s.v1 = s.v0; s.ldk1 = 1536; s.ldv1 = 2048; s.rowclamp = 1 << 20;
        att::attn_unit<0>(Z + row0 * LDZ + ZC_MQ + h * 192, LDZ, OBR + row0 * LDO + h * 128, LDO, s, 4, sc_mla, na0, qp_mla_ctx, lds);
    }
    if (MIX_MASK & 8) for (;;) {
        const unsigned u5 = grab(qword(p, lq, 5, 0), slot, c.tid); const unsigned u = u5 & 255u;
        if (u5 >= 256u * QREP) break;
        const int b = u >> 3, h = u & 7; const size_t row0 = (size_t)b * 256;
        att::Src s; s.k0 = Z + row0 * LDZ + ZC_NK + h * 128; s.v0 = Z + row0 * LDZ + ZC_NV + h * 128; s.ldk0 = LDZ; s.ldv0 = LDZ; s.n0 = 4; s.k1 = s.k0; s.v1 = s.v0; s.ldk1 = LDZ; s.ldv1 = LDZ; s.rowclamp = 1 << 20;
        att::attn_unit<1>(Z + row0 * LDZ + ZC_NQ + h * 128, LDZ, OBR + row0 * LDO + 2048 + h * 128, LDO, s, 4, sc_na, na0, qp_na, lds);
    }
    {
        unsigned* cq = (unsigned*)(((unsigned char*)p->ws) + WS_CTL) + 12288 + lq * 16;
        const int nb0 = l == 0 ? (TRI_PER_LAYER - TRI_EARLY + 3) / 4 : 0, nb1 = l + 1 < DEPTH ? (TRI_PER_LAYER - bg_first + 3) / 4 : 0;
        for (;;) {
            const int u = (int)grab(cq, slot, c.tid);
            if (u >= nb0 + nb1) break;
            int t0, te;
            if (u < nb0) { t0 = TRI_EARLY + 4 * u; te = TRI_PER_LAYER; }
            else { t0 = (l + 1) * TRI_PER_LAYER + bg_first + 4 * (u - nb0); te = (l + 2) * TRI_PER_LAYER; }
            prologue_transposes(c, p, t0, 1, t0 + 4 < te ? t0 + 4 : te);
        }
    }
}
constexpr int NPH = 12;
constexpr int N_PHASES = 1 + DEPTH * NPH;
constexpr int LDS_BYTES = LDS_STAGE + 256;
static_assert(att::LDS_END <= LDS_STAGE && 2 * hg::CH_STAGE <= LDS_STAGE, "attention / chain LDS");
#ifndef MK_LAUNCH_MODE
#define MK_LAUNCH_MODE 1
#endif

__global__ void __launch_bounds__(512, 2) mk_fwd(ParamsH p) {
    extern __shared__ __attribute__((aligned(16))) unsigned char lds_raw[];
    Ctx c; c.lds = (LAS unsigned char*)lds_raw; c.tid = threadIdx.x; c.lane = c.tid & 63; c.wid = __builtin_amdgcn_readfirstlane(c.tid >> 6); c.G = gridDim.x; c.bid = blockIdx.x;
    volatile LAS unsigned* bw = (volatile LAS unsigned*)(c.lds + LDS_STAGE);
    if (c.tid < 4) bw[c.tid] = 0u;
    __syncthreads();
    const PkPtr pk = (PkPtr)__builtin_amdgcn_kernarg_segment_ptr();
#define P_ (lp(pk))
    if (p.ph_hi - p.ph_lo > 1) (void)xcd_barrier_post((unsigned*)(((unsigned char*)P_->ws) + WS_CTL), bw);
#ifdef PROBE_THIN2
#define NREP_THIN (P_->ph_hi > 1000 ? 1 : 2)
#else
#define NREP_THIN 1
#endif
#ifdef PROBE_TR2
#define NREP_TR (P_->ph_hi > 1000 ? 1 : 2)
#else
#define NREP_TR 1
#endif
#ifdef PROBE_KPE2
#define NREP_KPE (P_->ph_hi > 1000 ? 1 : 2)
#else
#define NREP_KPE 1
#endif
#ifdef PROBE_G2
#define NREP_G2 (P_->ph_hi > 1000 ? 1 : 2)
#else
#define NREP_G2 1
#endif
#ifdef PROBE_MIX2
#define NREP_MIX (P_->ph_hi > 1000 ? 1 : 2)
#else
#define NREP_MIX 1
#endif
#ifdef PROBE_BAR2
#define SEAM_EXTRA if (P_->ph_hi < 1000) { xcd_barrier(bar_); }
#else
#define SEAM_EXTRA
#endif
#ifndef BG_UP
#define BG_UP 16
#endif
#ifndef BG_KV
#define BG_KV 2
#endif
#ifndef PH_MASK
#define PH_MASK 0xFFFFFFFF
#endif
#define EN(b) ((PH_MASK >> (b)) & 1)
#define IN(k) (P_->ph_lo <= (k) && (k) < P_->ph_hi)
#define SEAM(k) do { if (IN((k) + 1)) { XcdBarrier bar_; bar_.bar = (unsigned*)(((unsigned char*)P_->ws) + WS_CTL); bar_.x = xb_xcc_id(); bar_.st = (volatile LAS unsigned*)(c.lds + LDS_STAGE); xcd_barrier(bar_); SEAM_EXTRA } } while (0)

    if (EN(0) && IN(0)) {
        for (int rr = 0; rr < NREP_THIN; ++rr) {
        for (int r2 = 0; r2 < NREP_TR; ++r2) { prologue_transposes(c, P_, c.bid, c.G, TRI_EARLY); __syncthreads(); }
        prologue_modulation(c, P_); __syncthreads();
        prologue_misc(c, P_); __syncthreads(); }
        SEAM(0);
    }
    const int BG_NUP = ((NTOK / 256) * (FFN2 / 256)) % c.G ? c.G - ((NTOK / 256) * (FFN2 / 256)) % c.G : 0, BG_NKV = ((NKV / 256) * 8) % c.G ? c.G - ((NKV / 256) * 8) % c.G : 0;
    for (int l = 0; l < DEPTH; ++l) {
        const int pb = 1 + l * NPH;
#define wl (((unsigned char*)P_->ws) + WS_WT + (size_t)(l & 1) * WL_BYTES)
#define MODL ((const float*)(((unsigned char*)P_->ws) + WS_MOD) + (size_t)l * 5 * 6 * DM)
#define H ((bf16_t*)(((unsigned char*)P_->ws) + WS_H))
#define Z ((bf16_t*)(((unsigned char*)P_->ws) + WS_Z))
        if (EN(1) && IN(pb + 0)) { for (int rr = 0; rr < NREP_THIN; ++rr) phase_norm(c, P_, l, l == 0, ((const float*)P_->in[I_N1G]) + (size_t)l * DM, 0, 1);
            SEAM(pb + 0); }
        if (EN(2) && IN(pb + 1)) {
            pg8::Gemm g{H, (const bf16_t*)(wl + WL_IN), NTOK, NZ, DM, DM}; pg8::StaticOrder S; S.init(NTOK, NZ, c.G, c.bid);
            pg8::EpiStoreBf16 E{Z, LDZ};
            pg8::gemm_phase(c.lds, g, S, E);
            phase_kpe(c, P_, l);
#ifdef PROBE_GEMM2
            pg8::gemm_phase(c.lds, g, S, E);
#endif
            SEAM(pb + 1);
        }
        if (EN(3) && IN(pb + 2)) { phase_prep_tokens(c, P_, l); __syncthreads(); for (int rr = 0; rr < NREP_THIN; ++rr) { phase_prep_hgrn(c, P_, l); __syncthreads(); } SEAM(pb + 2); }
        if (EN(4) && IN(pb + 3)) {
            pg8::Gemm g{(const bf16_t*)(((unsigned char*)P_->ws) + WS_CKVN), (const bf16_t*)(wl + WL_KV), NKV, 2048, 512, 512}; pg8::StaticOrder S; S.init(NKV, 2048, c.G, c.bid);
            pg8::EpiStoreBf16T<false> E{(bf16_t*)(((unsigned char*)P_->ws) + WS_KVRAW), 2048};
            for (int rr = 0; rr < NREP_G2; ++rr) pg8::gemm_phase(c.lds, g, S, E);
            if (l + 1 < DEPTH && c.bid >= c.G - BG_NKV) { __syncthreads(); prologue_transposes(c, P_, (l + 1) * TRI_PER_LAYER + BG_UP * BG_NUP + (c.bid - (c.G - BG_NKV)), BG_NKV, (l + 1) * TRI_PER_LAYER + BG_UP * BG_NUP + BG_KV * BG_NKV); }
            SEAM(pb + 3);
        }
        if (EN(5) && IN(pb + 4)) { for (int rr = 0; rr < NREP_THIN; ++rr) phase_kfinal(c, P_, l); SEAM(pb + 4); }
        if (EN(6) && IN(pb + 5)) { for (int rr = 0; rr < NREP_MIX; ++rr) phase_mixers(c, P_, l, l + 4 * rr, BG_UP * BG_NUP + BG_KV * BG_NKV); SEAM(pb + 5); }
        if (EN(8) && IN(pb + 6)) {
            pg8::StaticOrder S; S.init(NTOK, DM, c.G, c.bid);
            pg8::Gemm g{(const bf16_t*)(((unsigned char*)P_->ws) + WS_OBR), (const bf16_t*)(wl + WL_BR), NTOK, DM, 3072, LDO}; pg8::EpiGate3 E{Z + ZC_GA, LDZ, H};
            for (int rr = 0; rr < NREP_G2; ++rr) pg8::gemm_phase(c.lds, g, S, E);
            SEAM(pb + 6);
        }
        if (EN(9) && IN(pb + 7)) {
            pg8::Gemm g{H, (const bf16_t*)(wl + WL_OUT), NTOK, DM, DM, DM}; pg8::StaticOrder S; S.init(NTOK, DM, c.G, c.bid);
            pg8::EpiResid E{((const float*)P_->in[I_XP]), ((const float*)P_->in[I_XS]), (bf16_t*)(((unsigned char*)P_->ws) + WS_XB), ((float*)P_->out), MODL + 2 * DM, l == 0 ? 1 : 0, 0};
            pg8::gemm_phase(c.lds, g, S, E);
            SEAM(pb + 7);
        }
        if (EN(10) && IN(pb + 8)) { for (int rr = 0; rr < NREP_THIN; ++rr) phase_norm(c, P_, l, false, ((const float*)P_->in[I_N2G]) + (size_t)l * DM, 3, 4); SEAM(pb + 8); }
        if (EN(11) && IN(pb + 9)) {
            pg8::Gemm g{H, (const bf16_t*)(wl + WL_UP), NTOK, FFN2, DM, DM}; pg8::StaticOrder S; S.init(NTOK, FFN2, c.G, c.bid);
            pg8::EpiConvAct E{(bf16_t*)(((unsigned char*)P_->ws) + WS_ACT), ((const float*)P_->in[I_CONVW]) + (size_t)l * 3 * FFN, ((const float*)P_->in[I_CONVB]) + (size_t)l * FFN, (float*)(((unsigned char*)P_->ws) + WS_EDGE)};
            pg8::gemm_phase(c.lds, g, S, E);
            if (l + 1 < DEPTH && c.bid >= c.G - BG_NUP) { __syncthreads(); prologue_transposes(c, P_, (l + 1) * TRI_PER_LAYER + (c.bid - (c.G - BG_NUP)), BG_NUP, (l + 1) * TRI_PER_LAYER + BG_UP * BG_NUP); }
            SEAM(pb + 9);
        }
        if (EN(12) && IN(pb + 10)) { phase_conv_fix(c, P_, l); SEAM(pb + 10); }
        if (EN(13) && IN(pb + 11)) {
            pg8::Gemm g{(const bf16_t*)(((unsigned char*)P_->ws) + WS_ACT), (const bf16_t*)(wl + WL_DN), NTOK, DM, FFN, FFN}; pg8::StaticOrder S; S.init(NTOK, DM, c.G, c.bid);
            pg8::EpiResid E{((const float*)P_->in[I_XP]), ((const float*)P_->in[I_XS]), (bf16_t*)(((unsigned char*)P_->ws) + WS_XB), ((float*)P_->out), MODL + 5 * DM, 0, l + 1 == DEPTH ? 1 : 0};
            pg8::gemm_phase(c.lds, g, S, E);
            if (l + 1 < DEPTH) SEAM(pb + 11);
        }
    }
#undef IN
#undef SEAM
#undef P_
#undef wl
#undef MODL
#undef H
#undef Z
}

extern "C" void kernel_launch(void* const* d_in, const int* in_sizes, int n_in, void* d_out, int out_size, void* d_ws, size_t ws_size, hipStream_t stream) {
    static int grid = 0;
    if (grid == 0) {
        if (n_in != 30 || (size_t)out_size != O_END || ws_size < WS_END) { fprintf(stderr, "kernel_launch: unexpected shapes (n_in %d out %d ws %zu need %zu)\n", n_in, out_size, ws_size, (size_t)WS_END); grid = -1; return; }
        int dev = 0, cus = 0, per_cu = 0;
        if (hipGetDevice(&dev) != hipSuccess || hipDeviceGetAttribute(&cus, hipDeviceAttributeMultiprocessorCount, dev) != hipSuccess) { grid = -1; return; }
        if (hipFuncSetAttribute((const void*)mk_fwd, hipFuncAttributeMaxDynamicSharedMemorySize, LDS_BYTES) != hipSuccess) { fprintf(stderr, "kernel_launch: hipFuncSetAttribute failed\n"); grid = -1; return; }
        if (hipOccupancyMaxActiveBlocksPerMultiprocessor(&per_cu, (const void*)mk_fwd, 512, LDS_BYTES) != hipSuccess || per_cu < 1) { fprintf(stderr, "kernel_launch: occupancy query says %d\n", per_cu); (void)hipGetLastError(); grid = -1; return; }
        grid = cus;
    }
    if (grid < 0) return;
    (void)hipMemsetAsync((char*)d_ws + WS_CTL, 0, CTL_BYTES, stream);
    ParamsH p{};
    for (int i = 0; i < 30; ++i) p.in[i] = (const float*)d_in[i];
    p.out = (float*)d_out; p.ws = (unsigned char*)d_ws;
#if MK_LAUNCH_MODE == 0
    for (int k = 0; k < N_PHASES; ++k) { p.ph_lo = k; p.ph_hi = k + 1; hipLaunchKernelGGL(mk_fwd, dim3(grid), dim3(512), LDS_BYTES, stream, p); }
#else
    p.ph_lo = 0; p.ph_hi = N_PHASES;
    hipLaunchKernelGGL(mk_fwd, dim3(grid), dim3(512), LDS_BYTES, stream, p);
#endif
    const hipError_t le = hipPeekAtLastError();
    if (le != hipSuccess) fprintf(stderr, "kernel_launch: launch failed: %s\n", hipGetErrorName(le));
}
```

```cpp
#include <hip/hip_runtime.h>
#include <cstdio>
#include <cstdint>

constexpr int DM = 2048;
constexpr int NTC = 8192, NTL = 16384, NTOK = NTC + NTL;
constexpr int NCACHE = 2048;
constexpr int NKV = NTOK + NCACHE;
constexpr int DEPTH = 4;
constexpr int LDZ = 16640;
constexpr int NIN_SRC = 16448;
constexpr int FFN = 5632, FFN2 = 11264;
constexpr int ZC_MQ = 0, ZC_CKV = 1536, ZC_HQ = 2048, ZC_HFF = 3072, ZC_HFB = 4096, ZC_HI = 5120, ZC_HG = 6144,
              ZC_NQ = 7168, ZC_NK = 8192, ZC_NV = 9216, ZC_GA = 10240, ZC_GB = 12288, ZC_GC = 14336;
constexpr int NZ = 16384;
constexpr int ZC_OF = ZC_HQ, ZC_OB = ZC_HFF, ZC_OMLA = ZC_HFB, ZC_ONA = ZC_HI, ZC_OHG = ZC_HG;
constexpr float EPS = 1e-6f;

typedef unsigned short bf16_t;
typedef short bf16x8 __attribute__((ext_vector_type(8)));
typedef short s16x4 __attribute__((ext_vector_type(4)));
typedef float f32x4 __attribute__((ext_vector_type(4)));
typedef float f32x2 __attribute__((ext_vector_type(2)));
typedef float f32x8 __attribute__((ext_vector_type(8)));
typedef float f32x16 __attribute__((ext_vector_type(16)));
typedef unsigned u32x4 __attribute__((ext_vector_type(4)));
typedef unsigned u32x2 __attribute__((ext_vector_type(2)));
typedef __bf16 bfv2 __attribute__((ext_vector_type(2)));

#define DI __device__ __forceinline__
#define LAS __attribute__((address_space(3)))

DI unsigned pk2(float lo, float hi) { f32x2 v = {lo, hi}; bfv2 r = __builtin_convertvector(v, bfv2); return __builtin_bit_cast(unsigned, r); }
DI bf16_t f2bf(float x) { return (bf16_t)(pk2(x, 0.f) & 0xffffu); }
DI float bf2f(bf16_t b) { return __uint_as_float(((unsigned)b) << 16); }
DI float bflo(unsigned w) { return __uint_as_float(w << 16); }
DI float bfhi(unsigned w) { return __uint_as_float(w & 0xffff0000u); }
DI float shfl_xor_l(float v, int o, int lane) { return __builtin_bit_cast(float, __builtin_amdgcn_ds_bpermute((lane ^ o) << 2, __builtin_bit_cast(int, v))); }
DI float wave_sum(float v, int lane) {
#pragma unroll
    for (int o = 32; o >= 1; o >>= 1) v += shfl_xor_l(v, o, lane);
    return v; }
template <int CTRL> DI float dpp_f(float v) { return __builtin_bit_cast(float, __builtin_amdgcn_update_dpp(0, __builtin_bit_cast(int, v), CTRL, 0xF, 0xF, true)); }
DI float group16_sum(float v) { v += dpp_f<0xB1>(v); v += dpp_f<0x4E>(v); v += dpp_f<0x141>(v); v += dpp_f<0x140>(v); return v; }
DI float wave_sum16(float v, int lane) { v = group16_sum(v); v += shfl_xor_l(v, 16, lane); v += shfl_xor_l(v, 32, lane); return v; }
DI void unpack8(const u32x4 w, float (&f)[8]) { f[0] = bflo(w.x); f[1] = bfhi(w.x); f[2] = bflo(w.y); f[3] = bfhi(w.y); f[4] = bflo(w.z); f[5] = bfhi(w.z); f[6] = bflo(w.w); f[7] = bfhi(w.w); }
DI u32x4 pack8f(const float (&f)[8]) { u32x4 w; w.x = pk2(f[0], f[1]); w.y = pk2(f[2], f[3]); w.z = pk2(f[4], f[5]); w.w = pk2(f[6], f[7]); return w; }
DI float sigmoidf_(float x) { return 1.0f / (1.0f + __expf(-x)); }

constexpr size_t al256(size_t x) { return (x + 255) / 256 * 256; }
constexpr size_t WS_CTL = 0;
constexpr size_t CTL_BYTES = 65536;
constexpr size_t WS_MOD = WS_CTL + CTL_BYTES;
constexpr size_t WS_LOWER = WS_MOD + al256((size_t)DEPTH * 5 * 6 * DM * 4);
constexpr size_t WS_ROPE = WS_LOWER + al256(2 * 4 * 1024 * 4);
constexpr size_t WS_WT = WS_ROPE + al256(2 * 64 * 16 * 4);
constexpr size_t WL_IN = 0;
constexpr size_t WL_KV = WL_IN + (size_t)LDZ * DM * 2;
constexpr size_t WL_BR = WL_KV + (size_t)2048 * 512 * 2;
constexpr size_t WL_OUT = WL_BR + (size_t)3 * DM * 1024 * 2;
constexpr size_t WL_UP = WL_OUT + (size_t)DM * DM * 2;
constexpr size_t WL_DN = WL_UP + (size_t)FFN2 * DM * 2;
constexpr size_t WL_KPE = WL_DN + (size_t)DM * FFN * 2;
constexpr size_t WL_BYTES = WL_KPE + (size_t)64 * DM * 2;
constexpr int WT_SLOTS = 2;
constexpr size_t WS_NAKC = WS_WT + (size_t)WT_SLOTS * WL_BYTES;
constexpr size_t WS_NAVC = WS_NAKC + (size_t)DEPTH * 4 * 512 * 1024 * 2;
constexpr size_t WS_H = WS_NAVC + (size_t)DEPTH * 4 * 512 * 1024 * 2;
constexpr size_t WS_Z = WS_H + (size_t)NTOK * DM * 2;
constexpr size_t WS_KVRAW = WS_Z + (size_t)NTOK * LDZ * 2;
constexpr size_t WS_CKVN = WS_KVRAW + (size_t)NKV * 2048 * 2;
constexpr size_t WS_KBUF = WS_CKVN + (size_t)NKV * 512 * 2;
constexpr size_t WS_MACC = WS_KVRAW;
constexpr size_t WS_HG = WS_KBUF + (size_t)NKV * 1536 * 2;
constexpr size_t HG_ARR = (size_t)NTOK * 1024 * 2;
constexpr size_t HG_QTF = 0, HG_KTF = HG_ARR, HG_KTTF = 2 * HG_ARR, HG_QTB = 3 * HG_ARR, HG_KTB = 4 * HG_ARR, HG_KTTB = 5 * HG_ARR, HG_VT = 6 * HG_ARR;
constexpr size_t HG_EV = 7 * HG_ARR;
constexpr size_t HG_BYTES = HG_EV + (size_t)768 * 8 * 2 * 2 * 128 * 4;
constexpr size_t WS_ACT = WS_HG;
constexpr size_t WS_OBR = WS_HG + HG_BYTES;
constexpr int LDO = 3072;
constexpr int LDS_STAGE = 135168;
constexpr int QSLOT_OFF = LDS_STAGE + 64;
constexpr size_t WS_EDGE = WS_KVRAW;
constexpr size_t WS_KPE = WS_OBR + (size_t)NTOK * LDO * 2;
constexpr size_t WS_XB = WS_KPE + (size_t)NTOK * 64 * 2;
constexpr size_t WS_END = WS_XB + (size_t)NTOK * DM * 2;
static_assert((size_t)192 * 2 * 3 * FFN * 4 <= (size_t)NKV * 2048 * 2, "EDGE alias");
static_assert((size_t)NTOK * DM * 4 <= (size_t)NKV * (2048 + 512 + 1536) * 2, "MACC alias");
static_assert((size_t)NTOK * FFN * 2 <= HG_BYTES, "ACT alias");

#define XB_TMO      128
#define XB_XCNT(j)  (256  + 64 * (j))
#define XB_XSUB(j)  (1280 + 64 * (j))
#define XB_XGEN(j)  (2304 + 64 * (j))
#define XB_TOP      3328
#define XB_TOPGEN   3392
#define XCD_BAR_WORDS 3456
#define XB_SPIN_CAP (1u << 23)

DI unsigned xb_ld(unsigned* p)              { return __hip_atomic_load(p, __ATOMIC_RELAXED, __HIP_MEMORY_SCOPE_AGENT); }
DI unsigned xb_add(unsigned* p, unsigned v) { return __hip_atomic_fetch_add(p, v, __ATOMIC_RELAXED, __HIP_MEMORY_SCOPE_AGENT); }
DI unsigned xb_xcc_id() { return (unsigned)__builtin_amdgcn_s_getreg((3 << 11) | 20) & 0xFu; }
#define XB_SPIN(cond, bar) do { unsigned _sp = 0; while (cond) { __builtin_amdgcn_s_sleep(1); \
    if ((++_sp & 255u) == 0u) { if (xb_ld(&(bar)[XB_TMO])) break; if (_sp > XB_SPIN_CAP) { atomicAdd(&(bar)[XB_TMO], 1u); break; } } } } while (0)

struct XcdBarrier { unsigned* bar; unsigned x; volatile LAS unsigned* st; };

DI XcdBarrier xcd_barrier_post(unsigned* bar, volatile LAS unsigned* st) {
    XcdBarrier b; b.bar = bar; b.x = xb_xcc_id(); b.st = st;
    if (threadIdx.x == 0) (void)xb_add(&bar[XB_XCNT(b.x)], 1u);
    return b;
}
DI void xcd_barrier_complete(unsigned* bar, unsigned x, unsigned& nloc, unsigned& nx) {
    const unsigned G = gridDim.x * gridDim.y * gridDim.z;
    unsigned sum, cnt, mine, sp = 0u;
    for (;;) {
        sum = 0u; cnt = 0u; mine = 0u;
#pragma unroll
        for (unsigned j = 0; j < 16; ++j) { const unsigned c = xb_ld(&bar[XB_XCNT(j)]); sum += c; cnt += (c > 0u) ? 1u : 0u; mine = (j == x) ? c : mine; }
        if (sum == G) break;
        __builtin_amdgcn_s_sleep(1);
        if ((++sp & 255u) == 0u) { if (xb_ld(&bar[XB_TMO])) break; if (sp > XB_SPIN_CAP) { atomicAdd(&bar[XB_TMO], 1u); break; } }
    }
    nloc = mine > 0u ? mine : 1u; nx = cnt > 0u ? cnt : 1u;
}
DI void xcd_barrier(const XcdBarrier& b) {
    asm volatile("s_waitcnt vmcnt(0)" ::: "memory");
    __syncthreads();
    if (threadIdx.x == 0) {
        __attribute__((address_space(1))) unsigned* gbar_ = (__attribute__((address_space(1))) unsigned*)b.bar; asm volatile("" : "+v"(gbar_)); unsigned* bar = (unsigned*)gbar_;
        __builtin_amdgcn_s_waitcnt(0);
        unsigned nloc = b.st[0], nx = b.st[1];
        if (nloc == 0u) { xcd_barrier_complete(bar, b.x, nloc, nx); b.st[0] = nloc; b.st[1] = nx; }
        const unsigned old = xb_add(&bar[XB_XSUB(b.x)], 1u);
        const unsigned gen = old / nloc;
        if (old + 1u == (gen + 1u) * nloc) {
            __builtin_amdgcn_fence(__ATOMIC_RELEASE, "agent");
            asm volatile("s_waitcnt vmcnt(0)" ::: "memory");
            const unsigned og = xb_add(&bar[XB_TOP], 1u);
            const unsigned tg = og / nx;
            if (og + 1u == (tg + 1u) * nx) xb_add(&bar[XB_TOPGEN], 1u);
            else XB_SPIN(xb_ld(&bar[XB_TOPGEN]) == tg, bar);
            __builtin_amdgcn_fence(__ATOMIC_ACQUIRE, "agent");
            xb_add(&bar[XB_XGEN(b.x)], 1u);
            asm volatile("s_waitcnt vmcnt(0)" ::: "memory");
        } else {
            XB_SPIN(xb_ld(&bar[XB_XGEN(b.x)]) == gen, bar);
            __builtin_amdgcn_fence(__ATOMIC_ACQUIRE, "agent");
            asm volatile("s_waitcnt vmcnt(0)" ::: "memory");
        }
    }
    __syncthreads();
}
namespace pg8 {
constexpr int BM = 256, BK = 64, HALF = 128, HTB = HALF * BK * 2, STAGE_BYTES = 8 * HTB, NXCD = 8, WGM = 4;

__host__ __device__ __forceinline__ int lds_byte(int r, int c) { const int st = (r >> 4) * 2 + (c >> 5), rr = r & 15, cc = c & 31, ob = rr * 64 + cc * 2; return st * 1024 + (ob ^ (((ob >> 9) & 1) << 5)); }
__host__ __device__ __forceinline__ void stage_rc(int b, int& R, int& C) { const int st = b / 1024, sb = b % 1024, swz = sb ^ (((sb >> 9) & 1) << 5); R = (st >> 1) * 16 + swz / 64; C = (st & 1) * 32 + (swz % 64) / 2; }
__host__ __device__ __forceinline__ int perm32(int rho) { const int n = rho >> 4, i = rho & 15; return 8 * (i >> 2) + 4 * n + (i & 3); }

struct Unit { int pm, pn; };
struct Gemm { const bf16_t* A; const bf16_t* Bt; int M, N, K, lda; };

struct StaticOrder {
    int nM, nN, nwg, G, c;
    __host__ __device__ void init(int M, int N, int G_, int c_) { nM = M / BM; nN = N / BM; nwg = nM * nN; G = G_; c = c_; }
    __host__ __device__ bool next(int i, Unit& u) const {
        const long L = (long)i * G + c; if (L >= nwg) return false;
        int wgid = (int)L; { const int q = nwg / NXCD, r = nwg % NXCD, xcd = wgid % NXCD, off = wgid / NXCD; wgid = (xcd < r ? xcd * (q + 1) : r * (q + 1) + (xcd - r) * q) + off; }
        const int nig = WGM * nN, gid = wgid / nig, fm = gid * WGM, gsz = (nM - fm) < WGM ? (nM - fm) : WGM;
        u.pm = fm + ((wgid % nig) % gsz); u.pn = (wgid % nig) / gsz; return true;
    }
    __device__ __forceinline__ void a_ready(const Unit&) const {}
    __device__ __forceinline__ void done(const Unit&) const {}
};

template <bool NT> struct EpiStoreBf16T {
    static constexpr bool PERM = true; static constexpr int MIDK = 0; static constexpr bool AROWPERM = false; static constexpr bool BJADJ = true;
    bf16_t* O; int ldc;
    __device__ __forceinline__ void operator()(const f32x4 (&acc)[2][2][4][2], const Unit& u, int wr, int wc, int fr, int fq) const {
        const int row0 = u.pm * BM + wr * 64 + fr, col0 = u.pn * BM + wc * 64 + 8 * fq;
#pragma unroll
        for (int ai = 0; ai < 2; ++ai)
#pragma unroll
            for (int m = 0; m < 4; ++m) { bf16_t* rowp = O + (size_t)(row0 + ai * HALF + m * 16) * ldc + col0;
#pragma unroll
                for (int bj = 0; bj < 2; ++bj) { const f32x4 v0 = acc[ai][bj][m][0], v1 = acc[ai][bj][m][1];
                    u32x4 w; w.x = pk2(v0[0], v0[1]); w.y = pk2(v0[2], v0[3]); w.z = pk2(v1[0], v1[1]); w.w = pk2(v1[2], v1[3]);
                    if (NT) __builtin_nontemporal_store(w, (u32x4*)(rowp + bj * 32)); else *(u32x4*)(rowp + bj * 32) = w; } }
    }
};
typedef EpiStoreBf16T<true> EpiStoreBf16;
struct EpiGate3 {
    static constexpr bool PERM = true; static constexpr int MIDK = 16; static constexpr bool AROWPERM = false; static constexpr bool BJADJ = false;
    const bf16_t* gate; int ldg;
    bf16_t* mout;
    static __device__ __forceinline__ float ratio(float a, float b) { return (1.0f + __expf(-b)) * __builtin_amdgcn_rcpf(1.0f + __expf(-a)); }
    __device__ __forceinline__ void mid(f32x4 (&acc)[2][2][4][2], const Unit& u, int seg, int wr, int wc, int fr, int fq) const {
        const int row0 = u.pm * BM + wr * 64 + fr, col0 = u.pn * BM + wc * 32 + 8 * fq;
        const bf16_t* g0 = gate + (size_t)row0 * ldg + col0 + seg * 2048;
        u32x4 ga[2][4], gb[2][4];
#define G3_LOAD(t, bf) do { _Pragma("unroll") for (int m = 0; m < 4; ++m) { const bf16_t* gp = g0 + (size_t)(((t) >> 1) * HALF + m * 16) * ldg + ((t) & 1) * HALF; \
            ga[bf][m] = *(const u32x4*)gp; gb[bf][m] = *(const u32x4*)(gp + 2048); } } while (0)
        G3_LOAD(0, 0);
#pragma unroll
        for (int t = 0; t < 4; ++t) {
            if (t + 1 < 4) G3_LOAD(t + 1, (t + 1) & 1);
            const int ai = t >> 1, bj = t & 1;
#pragma unroll
            for (int m = 0; m < 4; ++m) { const u32x4 a = ga[t & 1][m], b = gb[t & 1][m];
                f32x4& v0 = acc[ai][bj][m][0]; f32x4& v1 = acc[ai][bj][m][1];
                v0[0] *= ratio(bflo(a.x), bflo(b.x)); v0[1] *= ratio(bfhi(a.x), bfhi(b.x)); v0[2] *= ratio(bflo(a.y), bflo(b.y)); v0[3] *= ratio(bfhi(a.y), bfhi(b.y));
                v1[0] *= ratio(bflo(a.z), bflo(b.z)); v1[1] *= ratio(bfhi(a.z), bfhi(b.z)); v1[2] *= ratio(bflo(a.w), bflo(b.w)); v1[3] *= ratio(bfhi(a.w), bfhi(b.w)); }
            asm volatile("" ::: "memory"); }
#undef G3_LOAD
    }
    __device__ __forceinline__ void operator()(const f32x4 (&acc)[2][2][4][2], const Unit& u, int wr, int wc, int fr, int fq) const {
        const int row0 = u.pm * BM + wr * 64 + fr, col0 = u.pn * BM + wc * 32 + 8 * fq;
        u32x4 gc[2][4][2];
#pragma unroll
        for (int ai = 0; ai < 2; ++ai)
#pragma unroll
            for (int m = 0; m < 4; ++m)
#pragma unroll
                for (int bj = 0; bj < 2; ++bj) gc[ai][m][bj] = *(const u32x4*)(gate + (size_t)(row0 + ai * HALF + m * 16) * ldg + col0 + bj * HALF + 4096);
#pragma unroll
        for (int ai = 0; ai < 2; ++ai) {
#pragma unroll
            for (int m = 0; m < 4; ++m) { const size_t row = (size_t)(row0 + ai * HALF + m * 16);
#pragma unroll
                for (int bj = 0; bj < 2; ++bj) { const u32x4 g = gc[ai][m][bj];
                    f32x4 v0 = acc[ai][bj][m][0], v1 = acc[ai][bj][m][1];
                    v0[0] *= sigmoidf_(bflo(g.x)); v0[1] *= sigmoidf_(bfhi(g.x)); v0[2] *= sigmoidf_(bflo(g.y)); v0[3] *= sigmoidf_(bfhi(g.y));
                    v1[0] *= sigmoidf_(bflo(g.z)); v1[1] *= sigmoidf_(bfhi(g.z)); v1[2] *= sigmoidf_(bflo(g.w)); v1[3] *= sigmoidf_(bfhi(g.w));
                    u32x4 w; w.x = pk2(v0[0], v0[1]); w.y = pk2(v0[2], v0[3]); w.z = pk2(v1[0], v1[1]); w.w = pk2(v1[2], v1[3]);
                    *(u32x4*)(mout + row * DM + col0 + bj * HALF) = w; } }
            asm volatile("" ::: "memory"); }
    }
};
struct EpiConvAct {
    static constexpr bool PERM = true; static constexpr int MIDK = 0; static constexpr bool AROWPERM = true; static constexpr bool BJADJ = false;
    bf16_t* act; const float* cw; const float* cb; float* edge;
    __device__ __forceinline__ void operator()(const f32x4 (&acc)[2][2][4][2], const Unit& u, int wr, int wc, int fr, int fq) const {
        const int col0 = u.pn * 128 + wc * 32 + 8 * fq;
        const int tok0 = u.pm * BM + 128 * wr + 8 * fr;
        float w0[8], w1[8], w2[8], bs[8];
        { const f32x4 x0 = *(const f32x4*)(cw + col0), x1 = *(const f32x4*)(cw + col0 + 4), y0 = *(const f32x4*)(cw + FFN + col0), y1 = *(const f32x4*)(cw + FFN + col0 + 4);
          const f32x4 z0 = *(const f32x4*)(cw + 2 * FFN + col0), z1 = *(const f32x4*)(cw + 2 * FFN + col0 + 4), b0 = *(const f32x4*)(cb + col0), b1 = *(const f32x4*)(cb + col0 + 4);
#pragma unroll
          for (int j = 0; j < 4; ++j) { w0[j] = x0[j]; w0[4 + j] = x1[j]; w1[j] = y0[j]; w1[4 + j] = y1[j]; w2[j] = z0[j]; w2[4 + j] = z1[j]; bs[j] = b0[j]; bs[4 + j] = b1[j]; } }
        float gprev0[8], gnext7[8];
#pragma unroll
        for (int n = 0; n < 2; ++n)
#pragma unroll
            for (int j = 0; j < 4; ++j) { gprev0[4 * n + j] = dpp_f<0x111>(acc[1][1][3][n][j]); gnext7[4 * n + j] = dpp_f<0x101>(acc[0][1][0][n][j]); }
#pragma unroll
        for (int idx = 0; idx < 8; ++idx) { const int ai = idx >> 2, m = idx & 3;
            float y[8], o[8];
#pragma unroll
            for (int n = 0; n < 2; ++n)
#pragma unroll
                for (int j = 0; j < 4; ++j) { const int e = 4 * n + j;
                    const float gp = idx > 0 ? acc[(idx - 1) >> 2][1][(idx - 1) & 3][n][j] : gprev0[e];
                    const float gn = idx < 7 ? acc[(idx + 1) >> 2][1][(idx + 1) & 3][n][j] : gnext7[e];
                    y[e] = w0[e] * gp + w1[e] * acc[ai][1][m][n][j] + w2[e] * gn + bs[e];
                    o[e] = y[e] * sigmoidf_(y[e]) * acc[ai][0][m][n][j]; }
            *(u32x4*)(act + (size_t)(tok0 + idx) * FFN + col0) = pack8f(o);
            if ((idx == 0 && fr == 0) || (idx == 7 && fr == 15)) {
                float* e = edge + ((size_t)((u.pm * 2 + wr) * 2 + (idx == 7 ? 1 : 0)) * 3) * FFN + col0;
                *(f32x4*)e = (f32x4){y[0], y[1], y[2], y[3]}; *(f32x4*)(e + 4) = (f32x4){y[4], y[5], y[6], y[7]};
                *(f32x4*)(e + FFN) = acc[ai][0][m][0]; *(f32x4*)(e + FFN + 4) = acc[ai][0][m][1];
                *(f32x4*)(e + 2 * FFN) = acc[ai][1][m][0]; *(f32x4*)(e + 2 * FFN + 4) = acc[ai][1][m][1]; }
        }
    }
};
struct EpiResid {
    static constexpr bool PERM = true; static constexpr int MIDK = 0; static constexpr bool AROWPERM = false; static constexpr bool BJADJ = false;
    const float* xc; const float* xl;
    bf16_t* xb; float* out; const float* gmod;
    int in_f32, out_f32;
    __device__ __forceinline__ void operator()(const f32x4 (&acc)[2][2][4][2], const Unit& u, int wr, int wc, int fr, int fq) const {
        const int row0 = u.pm * BM + wr * 64 + fr, col0 = u.pn * BM + wc * 32 + 8 * fq;
        const int grp = u.pm < 32 ? 0 : 1 + ((u.pm - 32) >> 4);
        const float* gv = gmod + (size_t)grp * (6 * DM);
#define RESID_GATES() f32x4 gg[2][2]; _Pragma("unroll") for (int bj = 0; bj < 2; ++bj) { gg[bj][0] = *(const f32x4*)(gv + col0 + bj * HALF); gg[bj][1] = *(const f32x4*)(gv + col0 + bj * HALF + 4); }
#define RESID_OUT(Y0, Y1, RO) do { if (out_f32) { *(f32x4*)(out + (RO)) = (Y0); *(f32x4*)(out + (RO) + 4) = (Y1); } \
        else { u32x4 w_; w_.x = pk2((Y0)[0], (Y0)[1]); w_.y = pk2((Y0)[2], (Y0)[3]); w_.z = pk2((Y1)[0], (Y1)[1]); w_.w = pk2((Y1)[2], (Y1)[3]); *(u32x4*)(xb + (RO)) = w_; } } while (0)
        if (in_f32) {
#pragma unroll
            for (int ai = 0; ai < 2; ++ai)
#pragma unroll
                for (int mh = 0; mh < 2; ++mh) {
                    RESID_GATES();
                    f32x4 xo[2][2][2];
#pragma unroll
                    for (int mm = 0; mm < 2; ++mm) { const int row = row0 + ai * HALF + (2 * mh + mm) * 16;
                        const float* xr = (row < NTC) ? xc + (size_t)row * DM : xl + (size_t)(row - NTC) * DM;
#pragma unroll
                        for (int bj = 0; bj < 2; ++bj) { xo[mm][bj][0] = *(const f32x4*)(xr + col0 + bj * HALF); xo[mm][bj][1] = *(const f32x4*)(xr + col0 + bj * HALF + 4); } }
#pragma unroll
                    for (int mm = 0; mm < 2; ++mm) { const int m = 2 * mh + mm; const size_t ro = (size_t)(row0 + ai * HALF + m * 16) * DM + col0;
#pragma unroll
                        for (int bj = 0; bj < 2; ++bj) { const f32x4 y0 = xo[mm][bj][0] + gg[bj][0] * acc[ai][bj][m][0], y1 = xo[mm][bj][1] + gg[bj][1] * acc[ai][bj][m][1]; RESID_OUT(y0, y1, ro + bj * HALF); } }
                    asm volatile("" ::: "memory"); }
        } else {
#pragma unroll
            for (int ai = 0; ai < 2; ++ai) {
                RESID_GATES();
                u32x4 xw[4][2];
#pragma unroll
                for (int m = 0; m < 4; ++m)
#pragma unroll
                    for (int bj = 0; bj < 2; ++bj) xw[m][bj] = *(const u32x4*)(xb + (size_t)(row0 + ai * HALF + m * 16) * DM + col0 + bj * HALF);
#pragma unroll
                for (int m = 0; m < 4; ++m) { const size_t ro = (size_t)(row0 + ai * HALF + m * 16) * DM + col0;
#pragma unroll
                    for (int bj = 0; bj < 2; ++bj) { const u32x4 w = xw[m][bj];
                        const f32x4 y0 = (f32x4){bflo(w.x), bfhi(w.x), bflo(w.y), bfhi(w.y)} + gg[bj][0] * acc[ai][bj][m][0], y1 = (f32x4){bflo(w.z), bfhi(w.z), bflo(w.w), bfhi(w.w)} + gg[bj][1] * acc[ai][bj][m][1];
                        RESID_OUT(y0, y1, ro + bj * HALF); } }
                asm volatile("" ::: "memory"); }
        }
#undef RESID_OUT
#undef RESID_GATES
    }
};

template <class Epi, class Sched>
__device__ __forceinline__ void gemm_phase(LAS unsigned char* lds, const Gemm g, const Sched& S, const Epi& E) {
    int tid_ = threadIdx.x; asm volatile("" : "+v"(tid_));
    const int tid = tid_, wid = __builtin_amdgcn_readfirstlane(tid >> 6), lane = tid & 63, wr = wid >> 2, wc = wid & 3, fr = lane & 15, fq = lane >> 4;
    const int K = g.K, nt = K / BK, lda = g.lda;
    unsigned voffA[2], voffB[2];
#pragma unroll
    for (int i = 0; i < 2; ++i) { int R, C; stage_rc(tid * 16 + i * 8192, R, C); const int Rb = Epi::BJADJ ? (2 * (R & ~31) + perm32(R & 31)) : Epi::PERM ? ((R & ~31) + perm32(R & 31)) : R;
        const int Ra = Epi::AROWPERM ? (128 * ((R >> 6) & 1) + 8 * (R & 15) + ((R >> 4) & 3)) : R;
        voffA[i] = (unsigned)(Ra * lda + C) * 2u; voffB[i] = (unsigned)(Rb * K + C) * 2u; }
    const size_t kstep = (size_t)(BK * 2);
    const size_t hstepA = (size_t)(Epi::AROWPERM ? 4 : HALF) * lda * 2, hstepB = (size_t)(Epi::BJADJ ? 32 : HALF) * K * 2;
    const size_t tstepA = (size_t)BM * lda * 2, tstepB = (size_t)BM * K * 2;
    const unsigned ldsw = (unsigned)wid * 1024u;
    const int aoff = lds_byte(wr * 64 + fr, fq * 8), boff = lds_byte(wc * 32 + fr, fq * 8);
#define PG8_SA(b, h) (((b) * 2 + (h)) * HTB)
#define PG8_SB(b, h) ((4 + (b) * 2 + (h)) * HTB)
#define PG8_STAGE(bufoff, gbase, voff) do { _Pragma("unroll") for (int _i = 0; _i < 2; ++_i) \
        __builtin_amdgcn_global_load_lds((const unsigned*)((const char*)(gbase) + (voff)[_i]), (LAS unsigned*)(lds + (bufoff) + ldsw + _i * 8192), 16, 0, 0); } while (0)
#define PG8_LDA(dst, b, h) do { _Pragma("unroll") for (int m = 0; m < 4; ++m) _Pragma("unroll") for (int k = 0; k < 2; ++k) dst[m][k] = *(const LAS bf16x8*)(lds + PG8_SA(b, h) + aoff + m * 2048 + k * 1024); } while (0)
#define PG8_LDB(dst, b, h) do { _Pragma("unroll") for (int n = 0; n < 2; ++n) _Pragma("unroll") for (int k = 0; k < 2; ++k) dst[n][k] = *(const LAS bf16x8*)(lds + PG8_SB(b, h) + boff + n * 2048 + k * 1024); } while (0)
#define PG8_MMA(ai, bj, At, Bt) do { __builtin_amdgcn_s_setprio(1); _Pragma("unroll") for (int m = 0; m < 4; ++m) _Pragma("unroll") for (int n = 0; n < 2; ++n) _Pragma("unroll") for (int k = 0; k < 2; ++k) \
        acc[ai][bj][m][n] = __builtin_amdgcn_mfma_f32_16x16x32_bf16(Bt[n][k], At[m][k], acc[ai][bj][m][n], 0, 0, 0); __builtin_amdgcn_s_setprio(0); } while (0)
#define PG8_WAIT_V(n) asm volatile("s_waitcnt vmcnt(" #n ")" ::: "memory")
#define PG8_WAIT_L(n) asm volatile("s_waitcnt lgkmcnt(" #n ")" ::: "memory")
#define PG8_BAR __builtin_amdgcn_s_barrier()
#define PG8_SCHED __builtin_amdgcn_sched_barrier(0)
    Unit cur, nxt; int ui = 0;
    if (!S.next(0, cur)) return;
    f32x4 acc[2][2][4][2];
#pragma unroll
    for (int a = 0; a < 2; ++a)
#pragma unroll
        for (int b = 0; b < 2; ++b)
#pragma unroll
            for (int m = 0; m < 4; ++m)
#pragma unroll
                for (int n = 0; n < 2; ++n) acc[a][b][m][n] = (f32x4){0.f, 0.f, 0.f, 0.f};
    bf16x8 At[4][2], B0[2][2], B1[2][2];
    const char* cA = (const char*)g.A + (size_t)cur.pm * tstepA; const char* cB = (const char*)g.Bt + (size_t)cur.pn * tstepB;
    S.a_ready(cur);
    PG8_STAGE(PG8_SB(0, 0), cB, voffB); PG8_STAGE(PG8_SA(0, 0), cA, voffA); PG8_STAGE(PG8_SB(0, 1), cB + hstepB, voffB); PG8_STAGE(PG8_SA(0, 1), cA + hstepA, voffA);
    if (wr == 1) PG8_BAR;
    PG8_WAIT_V(4); PG8_BAR;
    PG8_STAGE(PG8_SB(1, 0), cB + kstep, voffB); PG8_STAGE(PG8_SA(1, 0), cA + kstep, voffA); PG8_STAGE(PG8_SB(1, 1), cB + hstepB + kstep, voffB);
    PG8_WAIT_V(6); PG8_BAR;
    for (;;) {
        const bool has_next = S.next(ui + 1, nxt);
        const char* nA = has_next ? (const char*)g.A + (size_t)nxt.pm * tstepA : cA; const char* nB = has_next ? (const char*)g.Bt + (size_t)nxt.pn * tstepB : cB;
        for (int t = 0; t < nt; t += 2) {
            const bool last = (t == nt - 2);
            const char* a1 = cA + (size_t)(t + 1) * kstep;
            const char* a2 = last ? nA : cA + (size_t)(t + 2) * kstep; const char* b2 = last ? nB : cB + (size_t)(t + 2) * kstep;
            const char* a3 = a2 + kstep; const char* b3 = b2 + kstep;
            if (last && has_next) S.a_ready(nxt);
            if constexpr (Epi::MIDK > 0) { if (t > 0 && (t % Epi::MIDK) == 0) E.mid(acc, cur, t / Epi::MIDK - 1, wr, wc, fr, fq); }
            PG8_LDB(B0, 0, 0); PG8_SCHED; PG8_LDA(At, 0, 0); PG8_STAGE(PG8_SA(1, 1), a1 + hstepA, voffA);
            PG8_WAIT_L(8); PG8_BAR; PG8_WAIT_L(0); PG8_MMA(0, 0, At, B0); PG8_BAR; PG8_SCHED;
            PG8_LDB(B1, 0, 1); PG8_STAGE(PG8_SB(0, 0), b2, voffB);
            PG8_BAR; PG8_WAIT_L(0); PG8_MMA(0, 1, At, B1); PG8_BAR;
            PG8_LDA(At, 0, 1); PG8_STAGE(PG8_SA(0, 0), a2, voffA);
            PG8_BAR; PG8_WAIT_L(0); PG8_MMA(1, 0, At, B0); PG8_BAR; PG8_SCHED;
            PG8_STAGE(PG8_SB(0, 1), b2 + hstepB, voffB);
            PG8_WAIT_V(6); PG8_BAR; PG8_MMA(1, 1, At, B1); PG8_BAR;
            PG8_LDB(B0, 1, 0); PG8_SCHED; PG8_LDA(At, 1, 0); PG8_STAGE(PG8_SA(0, 1), a2 + hstepA, voffA);
            PG8_WAIT_L(8); PG8_BAR; PG8_WAIT_L(0); PG8_MMA(0, 0, At, B0); PG8_BAR; PG8_SCHED;
            PG8_LDB(B1, 1, 1); PG8_STAGE(PG8_SB(1, 0), b3, voffB);
            PG8_BAR; PG8_WAIT_L(0); PG8_MMA(0, 1, At, B1); PG8_BAR;
            PG8_LDA(At, 1, 1); PG8_STAGE(PG8_SA(1, 0), a3, voffA);
            PG8_BAR; PG8_WAIT_L(0); PG8_MMA(1, 0, At, B0); PG8_BAR; PG8_SCHED;
            PG8_STAGE(PG8_SB(1, 1), b3 + hstepB, voffB);
            PG8_WAIT_V(6); PG8_BAR; PG8_MMA(1, 1, At, B1); PG8_BAR;
        }
        E(acc, cur, wr, wc, fr, fq); S.done(cur);
        if (!has_next) break;
#pragma unroll
        for (int a = 0; a < 2; ++a)
#pragma unroll
            for (int b = 0; b < 2; ++b)
#pragma unroll
                for (int m = 0; m < 4; ++m)
#pragma unroll
                    for (int n = 0; n < 2; ++n) acc[a][b][m][n] = (f32x4){0.f, 0.f, 0.f, 0.f};
        cur = nxt; cA = nA; cB = nB; ++ui;
    }
    PG8_WAIT_V(0);
    if (wr == 0) PG8_BAR;
    PG8_BAR;
#undef PG8_SA
#undef PG8_SB
#undef PG8_STAGE
#undef PG8_LDA
#undef PG8_LDB
#undef PG8_MMA
#undef PG8_WAIT_V
#undef PG8_WAIT_L
#undef PG8_BAR
#undef PG8_SCHED
}
}
typedef __attribute__((address_space(1))) float gf32_t;
typedef __attribute__((address_space(1))) unsigned char gu8_t;
struct ParamsH {
    const float* in[30];
    float* out;
    unsigned char* ws;
    int ph_lo, ph_hi;
};
struct Params {
    const gf32_t* in[30];
    gf32_t* out;
    gu8_t* ws;
    int ph_lo, ph_hi;
};
static_assert(sizeof(ParamsH) == sizeof(Params), "layout");
enum { I_XP = 0, I_XS, I_CCKV, I_CKPE, I_CNAK, I_CNAV, I_SHG, I_C, I_CCTX, I_WMOD, I_BMOD, I_N1G, I_N2G, I_WIN, I_KVG, I_QG, I_KG, I_WUK, I_WUV,
       I_LB, I_HGG, I_NAQG, I_NAKG, I_RPB, I_WBR, I_WOUT, I_WUP, I_CONVW, I_CONVB, I_WDN };
constexpr size_t O_YP = 0, O_YS = (size_t)NTC * DM, O_CKV = (size_t)NTOK * DM, O_KPE = O_CKV + (size_t)32 * 4 * 256 * 512,
                 O_NAK = O_KPE + (size_t)32 * 4 * 256 * 64, O_NAV = O_NAK + (size_t)32 * 4 * 256 * 1024, O_HGS = O_NAV + (size_t)32 * 4 * 256 * 1024,
                 O_END = O_HGS + (size_t)32 * 4 * 2 * 8 * 128 * 128;

struct Ctx {
    LAS unsigned char* lds; int tid, lane, wid, G, bid;
};
typedef const __attribute__((address_space(4))) Params* PkPtr;
DI PkPtr lp(PkPtr q) { asm volatile("" : "+s"(q)); return q; }
DI Ctx launder(const Ctx& c0) { Ctx c = c0; int t = c0.tid; asm volatile("" : "+v"(t)); c.tid = t; c.lane = t & 63; return c; }

constexpr int TRI_PER_LAYER = 256 * 8 + 8 + 2 * 16 * 2 + 3 * 32 * 4 + 32 * 8 + 176 * 8 + 32 * 22;
constexpr int TRI_EARLY = 256 * 8 + 8 + 2 * 16 * 2;
struct TrItem { const float* src; bf16_t* dst; int ldsrc, K; int zero; };
DI void tr_item(PkPtr p, int t, TrItem& it) {
    it.zero = 0;
    const int l = t / TRI_PER_LAYER; int r = t % TRI_PER_LAYER;
    bf16_t* wl = (bf16_t*)(((unsigned char*)p->ws) + WS_WT + (size_t)(l & 1) * WL_BYTES);
    if (r < 256 * 8) { const int nt = r / 8, kt = r % 8, n0 = nt * 64; const int sc = n0 < 2048 ? n0 : n0 + 64;
        it.src = ((const float*)p->in[I_WIN]) + (size_t)l * DM * NIN_SRC + (size_t)(kt * 256) * NIN_SRC + sc; it.ldsrc = NIN_SRC; it.K = DM; it.dst = wl + WL_IN / 2 + (size_t)n0 * DM + kt * 256; return; }
    r -= 256 * 8;
    if (r < 8) { const int kt = r;
        it.src = ((const float*)p->in[I_WIN]) + (size_t)l * DM * NIN_SRC + (size_t)(kt * 256) * NIN_SRC + 2048; it.ldsrc = NIN_SRC; it.K = DM; it.dst = wl + WL_KPE / 2 + kt * 256; return; }
    r -= 8;
    if (r < 64) { const int which = r / 32, q = r % 32, nt = q / 2, kt = q % 2;
        it.src = ((const float*)p->in[which ? I_WUV : I_WUK]) + (size_t)l * 512 * 1024 + (size_t)(kt * 256) * 1024 + nt * 64; it.ldsrc = 1024; it.K = 512; it.dst = wl + WL_KV / 2 + (size_t)(which * 1024 + nt * 64) * 512 + kt * 256; return; }
    r -= 64;
    if (r < 384) { const int i = r / 128, q = r % 128, nt = q / 4, kt = q % 4;
        it.src = ((const float*)p->in[I_WBR]) + ((size_t)l * 3 + i) * 1024 * DM + (size_t)(kt * 256) * DM + nt * 64; it.ldsrc = DM; it.K = 3072; it.dst = wl + WL_BR / 2 + (size_t)(nt * 64) * 3072 + i * 1024 + kt * 256; return; }
    r -= 384;
    if (r < 256) { const int nt = r / 8, kt = r % 8;
        it.src = ((const float*)p->in[I_WOUT]) + (size_t)l * DM * DM + (size_t)(kt * 256) * DM + nt * 64; it.ldsrc = DM; it.K = DM; it.dst = wl + WL_OUT / 2 + (size_t)(nt * 64) * DM + kt * 256; return; }
    r -= 256;
    if (r < 176 * 8) { const int nt = r / 8, kt = r % 8;
        const int half = nt / 88, np = (nt % 88) * 64, drow = 256 * (np / 128) + 128 * half + (np % 128);
        it.src = ((const float*)p->in[I_WUP]) + (size_t)l * DM * FFN2 + (size_t)(kt * 256) * FFN2 + nt * 64; it.ldsrc = FFN2; it.K = DM; it.dst = wl + WL_UP / 2 + (size_t)drow * DM + kt * 256; return; }
    r -= 176 * 8;
    { const int nt = r / 22, kt = r % 22;
        it.src = ((const float*)p->in[I_WDN]) + (size_t)l * FFN * DM + (size_t)(kt * 256) * DM + nt * 64; it.ldsrc = DM; it.K = FFN; it.dst = wl + WL_DN / 2 + (size_t)(nt * 64) * FFN + kt * 256; return; }
}
DI void prologue_transposes(const Ctx& c0, PkPtr p, int t0, int tstep, int t_end) {
    const Ctx c = launder(c0);
    LAS float* T = (LAS float*)c.lds;
    const int tid = c.tid, i = tid >> 4, j = (tid & 15) * 4, nn = tid >> 3, k8 = (tid & 7) * 8;
    f32x4 v[8];
    int t = t0;
    if (t >= t_end) return;
    TrItem cur; tr_item(p, t, cur);
    if (!cur.zero) {
#pragma unroll
        for (int q = 0; q < 8; ++q) v[q] = *(const f32x4*)(cur.src + (size_t)(i + 32 * q) * cur.ldsrc + j);
    }
    for (;;) {
        if (!cur.zero) {
#pragma unroll
            for (int q = 0; q < 8; ++q) { T[(j + 0) * 257 + i + 32 * q] = v[q][0]; T[(j + 1) * 257 + i + 32 * q] = v[q][1]; T[(j + 2) * 257 + i + 32 * q] = v[q][2]; T[(j + 3) * 257 + i + 32 * q] = v[q][3]; }
        }
        __syncthreads();
        const int tn = t + tstep; const bool more = tn < t_end;
        bf16_t* const cdst = cur.dst; const int cK = cur.K, czero = cur.zero;
        if (more) { tr_item(p, tn, cur);
            if (!cur.zero) {
#pragma unroll
                for (int q = 0; q < 8; ++q) v[q] = *(const f32x4*)(cur.src + (size_t)(i + 32 * q) * cur.ldsrc + j);
            } }
#pragma unroll
        for (int q = 0; q < 4; ++q) { u32x4 w = {0u, 0u, 0u, 0u};
            if (!czero) { const LAS float* r = T + nn * 257 + k8 + 64 * q; w.x = pk2(r[0], r[1]); w.y = pk2(r[2], r[3]); w.z = pk2(r[4], r[5]); w.w = pk2(r[6], r[7]); }
            *(u32x4*)(cdst + (size_t)nn * cK + k8 + 64 * q) = w; }
        __syncthreads();
        if (!more) break;
        t = tn;
    }
}

DI void prologue_modulation(const Ctx& c0, PkPtr p) {
    const Ctx c = launder(c0);
    LAS float* SC = (LAS float*)c.lds;
    LAS float* RED = SC + 5 * DM;
    for (int i = c.tid; i < 5 * DM; i += 512) { const int g = i / DM, k = i % DM; const float x = g == 0 ? ((const float*)p->in[I_CCTX])[k] : ((const float*)p->in[I_C])[(g - 1) * DM + k]; SC[i] = x * sigmoidf_(x); }
    __syncthreads();
    float* MOD = (float*)(((unsigned char*)p->ws) + WS_MOD);
    const int c4 = (c.tid & 15) * 4, ks = c.tid >> 4;
    for (int u = c.bid; u < DEPTH * 192; u += c.G) {
        const int l = u / 192, n0 = (u % 192) * 64;
        const float* w = ((const float*)p->in[I_WMOD]) + (size_t)l * DM * (6 * DM) + n0 + c4;
        f32x4 a0 = {0.f, 0.f, 0.f, 0.f}, a1 = a0, a2 = a0, a3 = a0, a4 = a0;
#pragma unroll 8
        for (int k = ks * 64; k < ks * 64 + 64; ++k) { const f32x4 wv = *(const f32x4*)(w + (size_t)k * (6 * DM));
            a0 += wv * SC[k]; a1 += wv * SC[DM + k]; a2 += wv * SC[2 * DM + k]; a3 += wv * SC[3 * DM + k]; a4 += wv * SC[4 * DM + k]; }
        *(LAS f32x4*)(RED + (ks * 5 + 0) * 64 + c4) = a0; *(LAS f32x4*)(RED + (ks * 5 + 1) * 64 + c4) = a1; *(LAS f32x4*)(RED + (ks * 5 + 2) * 64 + c4) = a2;
        *(LAS f32x4*)(RED + (ks * 5 + 3) * 64 + c4) = a3; *(LAS f32x4*)(RED + (ks * 5 + 4) * 64 + c4) = a4;
        __syncthreads();
        if (c.tid < 320) { const int g = c.tid >> 6, col = c.tid & 63; float s = ((const float*)p->in[I_BMOD])[(size_t)l * (6 * DM) + n0 + col];
#pragma unroll
            for (int q = 0; q < 32; ++q) s += RED[(q * 5 + g) * 64 + col];
            MOD[((size_t)l * 5 + g) * (6 * DM) + n0 + col] = s; }
        __syncthreads();
    }
}

DI void prologue_misc(const Ctx& c0, PkPtr p) {
    const Ctx c = launder(c0);
    float* LOW = (float*)(((unsigned char*)p->ws) + WS_LOWER);
    const int gt = c.bid * 512 + c.tid, GT = c.G * 512;
    for (int i = gt; i < 2 * 1024; i += GT) { const int d = i >> 10, ch = i & 1023; const float* s = ((const float*)p->in[I_LB]) + (size_t)d * 4 * 1024 + ch;
        const float x0 = s[0], x1 = s[1024], x2 = s[2048], x3 = s[3072]; const float mx = fmaxf(fmaxf(x0, x1), fmaxf(x2, x3));
        const float e0 = expf(x0 - mx), e1 = expf(x1 - mx), e2 = expf(x2 - mx), e3 = expf(x3 - mx); const float inv = 1.0f / (e0 + e1 + e2 + e3);
        float* o = LOW + (size_t)d * 4 * 1024 + ch; o[0] = 0.f; o[1024] = e1 * inv; o[2048] = (e1 + e2) * inv; o[3072] = (e1 + e2 + e3) * inv; }
    float* RT = (float*)(((unsigned char*)p->ws) + WS_ROPE);
    for (int i = gt; i < 1024; i += GT) { const int pos = i >> 4, f = i & 15; const float inv = powf(10000.0f, -(float)f / 16.0f); const float a = (float)pos * inv;
        RT[i] = cosf(a); RT[1024 + i] = sinf(a); }
    bf16_t* kc = (bf16_t*)(((unsigned char*)p->ws) + WS_NAKC); bf16_t* vc = (bf16_t*)(((unsigned char*)p->ws) + WS_NAVC);
    const size_t n8 = (size_t)4 * 4 * 512 * 1024 / 8;
    for (size_t i = gt; i < 2 * n8; i += GT) { const bool isv = i >= n8; const size_t j = isv ? i - n8 : i; const size_t e = j * 8;
        const size_t b = e / ((size_t)4 * 512 * 1024), rem = e % ((size_t)4 * 512 * 1024), l = rem / ((size_t)512 * 1024), r2 = rem % ((size_t)512 * 1024);
        const float* s = ((const float*)p->in[isv ? I_CNAV : I_CNAK]) + e; const f32x4 a = *(const f32x4*)s, bq = *(const f32x4*)(s + 4);
        u32x4 w; w.x = pk2(a[0], a[1]); w.y = pk2(a[2], a[3]); w.z = pk2(bq[0], bq[1]); w.w = pk2(bq[2], bq[3]);
        *(u32x4*)((isv ? vc : kc) + (l * 4 + b) * ((size_t)512 * 1024) + r2) = w; }
}

DI int row_group(int row) { return row < NTC ? 0 : 1 + ((row - NTC) >> 12); }

DI void phase_norm(const Ctx& c0, PkPtr p, int l, bool first, const float* gain, int ish, int isc) {
    const Ctx c = launder(c0);
    const float* MOD = (const float*)(((unsigned char*)p->ws) + WS_MOD) + (size_t)l * 5 * 6 * DM;
    bf16_t* H = (bf16_t*)(((unsigned char*)p->ws) + WS_H); const bf16_t* XB = (const bf16_t*)(((unsigned char*)p->ws) + WS_XB);
    const int nw = c.G * 8, per = (NTOK + nw - 1) / nw, r0 = (c.bid * 8 + c.wid) * per, r1 = r0 + per < NTOK ? r0 + per : NTOK;
    if (r0 >= r1) return;
    float v[4][8], av[4][8], sv[4][8]; f32x4 nf[4][2]; u32x4 nb[4]; int cur = -1;
#define NORM_LOAD(row) do { if (first) { const float* x_ = (row) < NTC ? ((const float*)p->in[I_XP]) + (size_t)(row) * DM : ((const float*)p->in[I_XS]) + (size_t)((row) - NTC) * DM; \
        _Pragma("unroll") for (int i = 0; i < 4; ++i) { nf[i][0] = *(const f32x4*)(x_ + i * 512 + c.lane * 8); nf[i][1] = *(const f32x4*)(x_ + i * 512 + c.lane * 8 + 4); } } \
    else { _Pragma("unroll") for (int i = 0; i < 4; ++i) nb[i] = *(const u32x4*)(XB + (size_t)(row) * DM + i * 512 + c.lane * 8); } } while (0)
    NORM_LOAD(r0);
    for (int row = r0; row < r1; ++row) {
        if (first) {
#pragma unroll
            for (int i = 0; i < 4; ++i)
#pragma unroll
                for (int j = 0; j < 4; ++j) { v[i][j] = nf[i][0][j]; v[i][4 + j] = nf[i][1][j]; }
        } else {
#pragma unroll
            for (int i = 0; i < 4; ++i) unpack8(nb[i], v[i]);
        }
        if (row + 1 < r1) NORM_LOAD(row + 1);
        const int grp = row_group(row);
        if (grp != cur) { cur = grp; const float* mg = MOD + (size_t)grp * 6 * DM;
#pragma unroll
            for (int i = 0; i < 4; ++i)
#pragma unroll
                for (int h2 = 0; h2 < 2; ++h2) { const int col = i * 512 + c.lane * 8 + 4 * h2;
                    const f32x4 a = *(const f32x4*)(gain + col) * (*(const f32x4*)(mg + isc * DM + col) + 1.0f), sft = *(const f32x4*)(mg + ish * DM + col);
#pragma unroll
                    for (int j = 0; j < 4; ++j) { av[i][4 * h2 + j] = a[j]; sv[i][4 * h2 + j] = sft[j]; } } }
        float ss = 0.f;
#pragma unroll
        for (int i = 0; i < 4; ++i)
#pragma unroll
            for (int j = 0; j < 8; ++j) ss += v[i][j] * v[i][j];
        ss = wave_sum(ss, c.lane);
        const float rinv = rsqrtf(ss * (1.0f / DM) + EPS);
#pragma unroll
        for (int i = 0; i < 4; ++i) { float y[8];
#pragma unroll
            for (int j = 0; j < 8; ++j) y[j] = v[i][j] * rinv * av[i][j] + sv[i][j];
            *(u32x4*)(H + (size_t)row * DM + i * 512 + c.lane * 8) = pack8f(y); }
    }
#undef NORM_LOAD
}

DI void phase_kpe(const Ctx& c0, PkPtr p, int l) {
    const Ctx c = launder(c0);
    const int lane = c.lane, r = lane & 31, hh = lane >> 5, ch = (c.bid >> 3) & 1, pairi = (c.bid & 7) + 8 * (c.bid >> 4);
    const bf16_t* Bg = (const bf16_t*)(((unsigned char*)p->ws) + WS_WT + (size_t)(l & 1) * WL_BYTES + WL_KPE) + (size_t)(ch * 32) * DM;
#pragma unroll
    for (int i = 0; i < 16; ++i) { const int sl = c.tid + 512 * i, row = sl >> 8, cchunk = (sl & 255) ^ (row & 15);
        __builtin_amdgcn_global_load_lds((const unsigned*)(Bg + (size_t)row * DM + cchunk * 8), (LAS unsigned*)(c.lds + (unsigned)(c.wid * 64 + 512 * i) * 16u), 16, 0, 0); }
    const int rbk = pairi * 6 + c.wid;
    const bool act = c.wid < 6 && rbk < NTOK / 32;
    const bf16_t* A = (const bf16_t*)(((unsigned char*)p->ws) + WS_H) + (size_t)((act ? rbk : 0) * 32 + r) * DM + 8 * hh;
    bf16x8 a[32];
    if (act) {
#pragma unroll
        for (int q = 0; q < 32; ++q) a[q] = *(const bf16x8*)(A + 16 * q);
    }
    asm volatile("s_waitcnt vmcnt(0)" ::: "memory"); __syncthreads();
    if (act) {
        f32x16 acc = f32x16{};
        const LAS char* brow = (const LAS char*)(c.lds + r * 4096);
        for (int k0 = 0; k0 < DM; k0 += 512) {
            bf16x8 an[32];
            if (k0 + 512 < DM) {
#pragma unroll
                for (int q = 0; q < 32; ++q) an[q] = *(const bf16x8*)(A + k0 + 512 + 16 * q);
            }
#pragma unroll
            for (int q = 0; q < 32; ++q) { const int chunk = (k0 >> 3) + 2 * q + hh;
                const bf16x8 bq = *(const LAS bf16x8*)(brow + ((chunk ^ (r & 15)) << 4));
                acc = __builtin_amdgcn_mfma_f32_32x32x16_bf16(a[q], bq, acc, 0, 0, 0); }
            if (k0 + 512 < DM) {
#pragma unroll
                for (int q = 0; q < 32; ++q) a[q] = an[q];
            }
        }
        bf16_t* O = (bf16_t*)(((unsigned char*)p->ws) + WS_KPE) + (size_t)(rbk * 32) * 64 + ch * 32;
#pragma unroll
        for (int i = 0; i < 16; ++i) { const int row = (i & 3) + 8 * (i >> 2) + 4 * hh; O[(size_t)row * 64 + r] = f2bf(acc[i]); }
    }
    __syncthreads();
}

DI void phase_prep_tokens(const Ctx& c0, PkPtr p, int l) {
    const Ctx c = launder(c0);
    bf16_t* Z = (bf16_t*)(((unsigned char*)p->ws) + WS_Z); bf16_t* CK = (bf16_t*)(((unsigned char*)p->ws) + WS_CKVN);
    const float* RT = (const float*)(((unsigned char*)p->ws) + WS_ROPE);
    const float* gq = ((const float*)p->in[I_QG]) + l * 192; const float* gkv = ((const float*)p->in[I_KVG]) + l * 512; const float* gnq = ((const float*)p->in[I_NAQG]) + l * 128; const float* gnk = ((const float*)p->in[I_NAKG]) + l * 128;
    float* out = (float*)p->out;
    const int lane = c.lane, g = lane >> 4, li = lane & 15;
    const bool qact = li < 12;
    float gqv[16], gkvv[8], gnqv[8], gnkv[8];
#pragma unroll
    for (int j = 0; j < 16; ++j) gqv[j] = qact ? gq[16 * li + j] : 0.f;
#pragma unroll
    for (int j = 0; j < 8; ++j) { gkvv[j] = gkv[8 * lane + j]; gnqv[j] = gnq[8 * li + j]; gnkv[j] = gnk[8 * li + j]; }
    for (int row = c.bid * 8 + c.wid; row < NTOK + NCACHE; row += c.G * 8) {
        if (row >= NTOK) {
            const int cr = row - NTOK, b = cr >> 9, pp = cr & 511;
            const float* s = ((const float*)p->in[I_CCKV]) + (((size_t)b * 4 + l) * 512 + pp) * 512 + lane * 8;
            const f32x4 a = *(const f32x4*)s, bq = *(const f32x4*)(s + 4);
            u32x4 w; w.x = pk2(a[0], a[1]); w.y = pk2(a[2], a[3]); w.z = pk2(bq[0], bq[1]); w.w = pk2(bq[2], bq[3]);
            *(u32x4*)(CK + (size_t)row * 512 + lane * 8) = w;
            continue;
        }
        bf16_t* zr = Z + (size_t)row * LDZ;
        const bool lat = row >= NTC;
        const int t = (row - NTC) & 4095, grow = t >> 6, gcol = t & 63;
        const int bb = row >> 8, ss_ = row & 255;
        const size_t obase = ((size_t)bb * 4 + l) * 256 + ss_;
        u32x4 qw[2][2], ckw, nqw[2], nkw[2], nvw[2]; bf16_t kpev = 0;
#pragma unroll
        for (int pass = 0; pass < 2; ++pass) { const bf16_t* q = zr + ZC_MQ + (4 * pass + g) * 192 + 16 * li;
            qw[pass][0] = (u32x4){0u, 0u, 0u, 0u}; qw[pass][1] = qw[pass][0];
            if (qact) { qw[pass][0] = *(const u32x4*)q; qw[pass][1] = *(const u32x4*)(q + 8); }
            nqw[pass] = *(const u32x4*)(zr + ZC_NQ + (4 * pass + g) * 128 + 8 * li); nkw[pass] = *(const u32x4*)(zr + ZC_NK + (4 * pass + g) * 128 + 8 * li);
            nvw[pass] = (u32x4){0u, 0u, 0u, 0u}; if (!lat) nvw[pass] = *(const u32x4*)(zr + ZC_NV + (4 * pass + g) * 128 + 8 * li); }
        ckw = *(const u32x4*)(zr + ZC_CKV + 8 * lane);
        if (!lat) kpev = ((const bf16_t*)(((unsigned char*)p->ws) + WS_KPE))[(size_t)row * 64 + lane];
        { float e[8]; unpack8(ckw, e); float s = 0.f;
#pragma unroll
            for (int j = 0; j < 8; ++j) s += e[j] * e[j];
            s = wave_sum16(s, lane); const float ri = rsqrtf(s * (1.0f / 512.0f) + EPS);
#pragma unroll
            for (int j = 0; j < 8; ++j) e[j] = e[j] * ri * gkvv[j];
            *(u32x4*)(CK + (size_t)row * 512 + 8 * lane) = pack8f(e);
            if (!lat) { float* o = out + O_CKV + obase * 512 + 8 * lane; *(f32x4*)o = (f32x4){e[0], e[1], e[2], e[3]}; *(f32x4*)(o + 4) = (f32x4){e[4], e[5], e[6], e[7]}; } }
        if (!lat) out[O_KPE + obase * 64 + lane] = bf2f(kpev);
#pragma unroll
        for (int pass = 0; pass < 2; ++pass) { const int h = 4 * pass + g;
            { bf16_t* k = zr + ZC_NK + h * 128 + 8 * li; float e[8]; unpack8(nkw[pass], e); float s = 0.f;
#pragma unroll
              for (int j = 0; j < 8; ++j) s += e[j] * e[j];
              s = group16_sum(s); const float ri = rsqrtf(s * (1.0f / 128.0f) + EPS);
#pragma unroll
              for (int j = 0; j < 8; ++j) e[j] = e[j] * ri * gnkv[j];
              *(u32x4*)k = pack8f(e);
              if (!lat) { float* o = out + O_NAK + (obase * 8 + h) * 128 + 8 * li; *(f32x4*)o = (f32x4){e[0], e[1], e[2], e[3]}; *(f32x4*)(o + 4) = (f32x4){e[4], e[5], e[6], e[7]};
                  float v[8]; unpack8(nvw[pass], v);
                  float* ov = out + O_NAV + (obase * 8 + h) * 128 + 8 * li; *(f32x4*)ov = (f32x4){v[0], v[1], v[2], v[3]}; *(f32x4*)(ov + 4) = (f32x4){v[4], v[5], v[6], v[7]}; } }
        }
    }
}

DI int ev_perm(int k) { const int kb = k >> 5, kr = k & 31; return kb * 32 + ((kr >> 2) & 1) * 16 + (kr & 3) + 4 * (kr >> 3); }
DI float clampe(float x) { return fminf(fmaxf(x, -50.f), 50.f); }

DI void phase_prep_hgrn(const Ctx& c0, PkPtr p, int l) {
    const Ctx c = launder(c0);
    const bf16_t* Z = (const bf16_t*)(((unsigned char*)p->ws) + WS_Z);
    unsigned char* HG = ((unsigned char*)p->ws) + WS_HG;
    const float* LOW = (const float*)(((unsigned char*)p->ws) + WS_LOWER);
    const int lane = c.lane, cg = lane & 15, tq = lane >> 4;
    for (int hu = c.bid * 8 + c.wid; hu < 768 * 8 * 2; hu += c.G * 8) {
        const int u = hu >> 1, k0 = 64 * (hu & 1) + 4 * cg;
        const int chunk = u >> 3, h = u & 7;
        const bf16_t* zb = Z + (size_t)(chunk * 32 + 8 * tq) * LDZ + h * 128 + k0;
        bf16_t* VT = (bf16_t*)(HG + HG_VT) + (size_t)u * 4096;
        float* EV = (float*)(HG + HG_EV) + (size_t)u * 512;
        { u32x2 v[8];
#pragma unroll
          for (int i = 0; i < 8; ++i) v[i] = *(const u32x2*)(zb + (size_t)i * LDZ + ZC_HI);
#pragma unroll
          for (int j2 = 0; j2 < 2; ++j2) {
              u32x4 lo, hi;
              lo.x = (v[0][j2] & 0xffffu) | (v[1][j2] << 16); lo.y = (v[2][j2] & 0xffffu) | (v[3][j2] << 16); lo.z = (v[4][j2] & 0xffffu) | (v[5][j2] << 16); lo.w = (v[6][j2] & 0xffffu) | (v[7][j2] << 16);
              hi.x = (v[0][j2] >> 16) | (v[1][j2] & 0xffff0000u); hi.y = (v[2][j2] >> 16) | (v[3][j2] & 0xffff0000u); hi.z = (v[4][j2] >> 16) | (v[5][j2] & 0xffff0000u); hi.w = (v[6][j2] >> 16) | (v[7][j2] & 0xffff0000u);
              *(u32x4*)(VT + (k0 + 2 * j2) * 32 + 8 * tq) = lo; *(u32x4*)(VT + (k0 + 2 * j2 + 1) * 32 + 8 * tq) = hi; } }
        float q[8][4];
#pragma unroll
        for (int i = 0; i < 8; ++i) { const u32x2 w = *(const u32x2*)(zb + (size_t)i * LDZ + ZC_HQ); const float x0 = bflo(w.x), x1 = bfhi(w.x), x2 = bflo(w.y), x3 = bfhi(w.y);
            q[i][0] = x0 * sigmoidf_(x0); q[i][1] = x1 * sigmoidf_(x1); q[i][2] = x2 * sigmoidf_(x2); q[i][3] = x3 * sigmoidf_(x3); }
#pragma unroll
        for (int dir = 0; dir < 2; ++dir) {
            const f32x4 lbv = *(const f32x4*)(LOW + (dir * 4 + l) * 1024 + h * 128 + k0);
            float lf[8][4], kk[8][4];
#pragma unroll
            for (int i = 0; i < 8; ++i) { const u32x2 w = *(const u32x2*)(zb + (size_t)i * LDZ + (dir ? ZC_HFB : ZC_HFF)); const float x[4] = {bflo(w.x), bfhi(w.x), bflo(w.y), bfhi(w.y)};
#pragma unroll
                for (int j = 0; j < 4; ++j) { const float e = __expf(-x[j]), s = 1.0f / (1.0f + e); const float f = lbv[j] + (1.0f - lbv[j]) * s;
                    lf[i][j] = fmaxf(__log2f(f), -100.f); kk[i][j] = (1.0f - lbv[j]) * (e * s); } }
            if (dir == 0) {
#pragma unroll
                for (int i = 1; i < 8; ++i)
#pragma unroll
                    for (int j = 0; j < 4; ++j) lf[i][j] += lf[i - 1][j];
            } else {
#pragma unroll
                for (int i = 6; i >= 0; --i)
#pragma unroll
                    for (int j = 0; j < 4; ++j) lf[i][j] += lf[i + 1][j];
            }
            float off[4], mid[4], last[4];
#pragma unroll
            for (int j = 0; j < 4; ++j) { const float own = dir == 0 ? lf[7][j] : lf[0][j];
                const float x16 = shfl_xor_l(own, 16, lane), x32 = shfl_xor_l(own, 32, lane), x48 = shfl_xor_l(own, 48, lane);
                const float t0 = tq == 0 ? own : tq == 1 ? x16 : tq == 2 ? x32 : x48;
                const float t1 = tq == 1 ? own : tq == 0 ? x16 : tq == 3 ? x32 : x48;
                const float t2 = tq == 2 ? own : tq == 3 ? x16 : tq == 0 ? x32 : x48;
                const float t3 = tq == 3 ? own : tq == 2 ? x16 : tq == 1 ? x32 : x48;
                if (dir == 0) { off[j] = (tq > 0 ? t0 : 0.f) + (tq > 1 ? t1 : 0.f) + (tq > 2 ? t2 : 0.f); mid[j] = t0 + t1; }
                else { off[j] = (tq < 3 ? t3 : 0.f) + (tq < 2 ? t2 : 0.f) + (tq < 1 ? t1 : 0.f); mid[j] = t2 + t3; }
                last[j] = t0 + t1 + t2 + t3; }
            bf16_t* QT = (bf16_t*)(HG + (dir ? HG_QTB : HG_QTF)) + (size_t)u * 4096; bf16_t* KT = (bf16_t*)(HG + (dir ? HG_KTB : HG_KTF)) + (size_t)u * 4096; bf16_t* KTT = (bf16_t*)(HG + (dir ? HG_KTTB : HG_KTTF)) + (size_t)u * 4096;
#pragma unroll
            for (int i = 0; i < 8; ++i) { float qo[4];
#pragma unroll
                for (int j = 0; j < 4; ++j) { const float b_ = lf[i][j] + off[j]; qo[j] = q[i][j] * exp2f(clampe(b_ - mid[j])); kk[i][j] = kk[i][j] * exp2f(clampe(mid[j] - b_)); }
                u32x2 wq; wq.x = pk2(qo[0], qo[1]); wq.y = pk2(qo[2], qo[3]); *(u32x2*)(QT + (8 * tq + i) * 128 + k0) = wq;
                u32x2 wk; wk.x = pk2(kk[i][0], kk[i][1]); wk.y = pk2(kk[i][2], kk[i][3]); *(u32x2*)(KT + (8 * tq + i) * 128 + k0) = wk; }
#pragma unroll
            for (int j = 0; j < 4; ++j) { u32x4 w; w.x = pk2(kk[0][j], kk[1][j]); w.y = pk2(kk[2][j], kk[3][j]); w.z = pk2(kk[4][j], kk[5][j]); w.w = pk2(kk[6][j], kk[7][j]);
                *(u32x4*)(KTT + (k0 + j) * 32 + 8 * tq) = w; }
            if (tq == 0) {
#pragma unroll
                for (int j = 0; j < 4; ++j) { const int pi = ev_perm(k0 + j); EV[dir * 256 + pi] = exp2f(mid[j]); EV[dir * 256 + 128 + pi] = exp2f(last[j] - mid[j]); } }
        }
    }
}

DI void phase_kfinal(const Ctx& c0, PkPtr p, int l) {
    const Ctx c = launder(c0);
    const bf16_t* Z = (const bf16_t*)(((unsigned char*)p->ws) + WS_Z); const bf16_t* KV = (const bf16_t*)(((unsigned char*)p->ws) + WS_KVRAW); bf16_t* KB = (bf16_t*)(((unsigned char*)p->ws) + WS_KBUF);
    const float* RT = (const float*)(((unsigned char*)p->ws) + WS_ROPE);
    const float* gk = ((const float*)p->in[I_KG]) + l * 192; const int lane = c.lane, g = lane >> 4, li = lane & 15;
    float gn[8], gp[4];
#pragma unroll
    for (int j = 0; j < 8; ++j) gn[j] = gk[8 * li + j];
#pragma unroll
    for (int j = 0; j < 4; ++j) gp[j] = gk[128 + 4 * li + j];
    for (int row = c.bid * 8 + c.wid; row < NKV; row += c.G * 8) {
        const bool lat = row >= NTC && row < NTOK;
        float pe[4];
        if (row < NTOK) { const u32x2 w = *(const u32x2*)((const bf16_t*)(((unsigned char*)p->ws) + WS_KPE) + (size_t)row * 64 + 4 * li); pe[0] = bflo(w.x); pe[1] = bfhi(w.x); pe[2] = bflo(w.y); pe[3] = bfhi(w.y); }
        else { const int cr = row - NTOK, b = cr >> 9, pp = cr & 511; const f32x4 w = *(const f32x4*)(((const float*)p->in[I_CKPE]) + (((size_t)b * 4 + l) * 512 + pp) * 64 + 4 * li); pe[0] = w[0]; pe[1] = w[1]; pe[2] = w[2]; pe[3] = w[3]; }
        f32x4 rc = {1.f, 1.f, 1.f, 1.f}, rs = {0.f, 0.f, 0.f, 0.f};
        if (lat) { const int t = (row - NTC) & 4095; const int pos = li < 8 ? (t >> 6) : (t & 63); rc = *(const f32x4*)(RT + pos * 16 + ((4 * li) & 15)); rs = *(const f32x4*)(RT + 1024 + pos * 16 + ((4 * li) & 15)); }
        const float pe2 = group16_sum(pe[0] * pe[0] + pe[1] * pe[1] + pe[2] * pe[2] + pe[3] * pe[3]);
        u32x4 knw[2];
#pragma unroll
        for (int pass = 0; pass < 2; ++pass) knw[pass] = *(const u32x4*)(KV + (size_t)row * 2048 + (4 * pass + g) * 128 + 8 * li);
#pragma unroll
        for (int pass = 0; pass < 2; ++pass) { const int h = 4 * pass + g;
            float e[8]; unpack8(knw[pass], e); float s = 0.f;
#pragma unroll
            for (int j = 0; j < 8; ++j) s += e[j] * e[j];
            s = group16_sum(s) + pe2; const float ri = rsqrtf(s * (1.0f / 192.0f) + EPS);
#pragma unroll
            for (int j = 0; j < 8; ++j) e[j] = e[j] * ri * gn[j];
            float y[4];
#pragma unroll
            for (int j = 0; j < 4; ++j) { float v = pe[j] * ri * gp[j]; const float pr = shfl_xor_l(v, 4, lane);
                y[j] = (li & 4) ? pr * rs[j] + v * rc[j] : v * rc[j] - pr * rs[j]; }
            bf16_t* o = KB + ((size_t)row * 8 + h) * 192;
            *(u32x4*)(o + 8 * li) = pack8f(e);
            u32x2 w; w.x = pk2(y[0], y[1]); w.y = pk2(y[2], y[3]); *(u32x2*)(o + 128 + 4 * li) = w; }
    }
}

DI void phase_hg_combine(const Ctx& c0, PkPtr p, int l) {
    const Ctx c = launder(c0);
    bf16_t* Z = (bf16_t*)(((unsigned char*)p->ws) + WS_Z); bf16_t* OBR = (bf16_t*)(((unsigned char*)p->ws) + WS_OBR); const float* gg = ((const float*)p->in[I_HGG]) + l * 128; const int lane = c.lane, g = lane >> 4, li = lane & 15;
    float gv[8];
#pragma unroll
    for (int j = 0; j < 8; ++j) gv[j] = gg[8 * li + j];
    for (int row = c.bid * 8 + c.wid; row < NTOK; row += c.G * 8) {
        bf16_t* zr = Z + (size_t)row * LDZ;
#pragma unroll
        for (int pass = 0; pass < 2; ++pass) { const int h = 4 * pass + g;
            float a[8], b[8], x[8]; unpack8(*(const u32x4*)(zr + ZC_OF + h * 128 + 8 * li), a); unpack8(*(const u32x4*)(zr + ZC_OB + h * 128 + 8 * li), b); unpack8(*(const u32x4*)(zr + ZC_HG + h * 128 + 8 * li), x);
            float s = 0.f;
#pragma unroll
            for (int j = 0; j < 8; ++j) { a[j] += b[j]; s += a[j] * a[j]; }
            s = group16_sum(s); const float ri = rsqrtf(s * (1.0f / 128.0f) + EPS);
#pragma unroll
            for (int j = 0; j < 8; ++j) a[j] = a[j] * ri * gv[j] * (x[j] * sigmoidf_(x[j]));
            *(u32x4*)(OBR + (size_t)row * LDO + 1024 + h * 128 + 8 * li) = pack8f(a); }
    }
}

DI void phase_conv_fix(const Ctx& c0, PkPtr p, int l) {
    const Ctx c = launder(c0);
    bf16_t* ACT = (bf16_t*)(((unsigned char*)p->ws) + WS_ACT); const float* EDGE = (const float*)(((unsigned char*)p->ws) + WS_EDGE);
    const float* cw = ((const float*)p->in[I_CONVW]) + (size_t)l * 3 * FFN;
    const int nvec = FFN / 4;
    for (int it = c.bid * 512 + c.tid; it < 191 * nvec; it += c.G * 512) {
        const int k = 1 + it / nvec, col = (it % nvec) * 4;
        const int T = 128 * k;
        const bool seqstart = T < NTC ? ((T & 255) == 0) : (((T - NTC) & 4095) == 0);
        if (seqstart) continue;
        const float* eL = EDGE + ((size_t)((k - 1) * 2 + 1) * 3) * FFN + col;
        const float* eF = EDGE + ((size_t)(k * 2 + 0) * 3) * FFN + col;
        const f32x4 yL = *(const f32x4*)eL, aL = *(const f32x4*)(eL + FFN), gL = *(const f32x4*)(eL + 2 * FFN);
        const f32x4 yF = *(const f32x4*)eF, aF = *(const f32x4*)(eF + FFN), gF = *(const f32x4*)(eF + 2 * FFN);
        const f32x4 w0 = *(const f32x4*)(cw + col), w2 = *(const f32x4*)(cw + 2 * FFN + col);
        float oL[4], oF[4];
#pragma unroll
        for (int j = 0; j < 4; ++j) { const float y1 = yL[j] + w2[j] * gF[j]; oL[j] = y1 * sigmoidf_(y1) * aL[j]; const float y2 = yF[j] + w0[j] * gL[j]; oF[j] = y2 * sigmoidf_(y2) * aF[j]; }
        u32x2 wl_; wl_.x = pk2(oL[0], oL[1]); wl_.y = pk2(oL[2], oL[3]); *(u32x2*)(ACT + (size_t)(T - 1) * FFN + col) = wl_;
        u32x2 wf_; wf_.x = pk2(oF[0], oF[1]); wf_.y = pk2(oF[2], oF[3]); *(u32x2*)(ACT + (size_t)T * FFN + col) = wf_;
    }
}
namespace att {
constexpr int NW = 8, QBLK = 32, KVBLK = 64;
constexpr int SHM_V = KVBLK * 128 * 2, SHM_K = KVBLK * 128 * 2, SHM_KR = KVBLK * 64 * 2;
constexpr int OFF_V = 0, OFF_K = 2 * SHM_V, OFF_KR = OFF_K + 2 * SHM_K, OFF_WS = OFF_KR + 2 * SHM_KR, OFF_QR = OFF_WS + NW * 256, OFF_RPB = OFF_QR + NW * 4096, LDS_END = OFF_RPB + 2048;
constexpr float LOG2E = 1.4426950408889634f;
constexpr float THR = 8.f;
#define KSWZ(row, colB) ((row) * 256 + ((colB) ^ (((row) & 7) << 4)))
#define KRSWZ(row, colB) ((row) * 128 + ((colB) ^ (((row) & 7) << 4)))
#define SBAR() __builtin_amdgcn_sched_barrier(0)
DI int crow(int r, int hi) { return (r & 3) + 8 * (r >> 2) + 4 * hi; }

struct Src {
    const bf16_t* k0; const bf16_t* v0; int ldk0, ldv0, n0;
    const bf16_t* k1; const bf16_t* v1; int ldk1, ldv1;
    int rowclamp;
    DI void get(int j, const bf16_t*& kp, const bf16_t*& vp, int& ldk, int& ldv) const {
        if (j < n0) { const int jj = j < rowclamp ? j : rowclamp; kp = k0 + (size_t)jj * 64 * ldk0; vp = v0 + (size_t)jj * 64 * ldv0; ldk = ldk0; ldv = ldv0; }
        else { kp = k1 + (size_t)(j - n0) * 64 * ldk1; vp = v1 + (size_t)(j - n0) * 64 * ldv1; ldk = ldk1; ldv = ldv1; }
    }
};
struct NaInfo { int nloc, lo, qrow; const LAS float* rpb; };
struct QPrep { const float* gain; const float* rope; int tok0; };

DI void partialSM(f32x16& p0, f32x16& p1, float& m_reg, float& mn, float& alpha, const float C, const float thr_raw) {
    float pmax = p0[0];
#pragma unroll
    for (int r = 1; r < 16; ++r) pmax = fmaxf(pmax, p0[r]);
#pragma unroll
    for (int r = 0; r < 16; ++r) pmax = fmaxf(pmax, p1[r]);
    { auto rr = __builtin_amdgcn_permlane32_swap(__float_as_uint(pmax), __float_as_uint(pmax), false, false);
      pmax = fmaxf(__uint_as_float(rr[0]), __uint_as_float(rr[1])); }
    if (__builtin_expect(__all(pmax - m_reg <= thr_raw), 1)) { mn = m_reg; alpha = 1.f; }
    else { mn = fmaxf(m_reg, pmax); alpha = __builtin_amdgcn_exp2f((m_reg - mn) * C); m_reg = mn; }
    const float mnC = -mn * C;
#pragma unroll
    for (int r = 0; r < 16; ++r) p0[r] = fmaf(p0[r], C, mnC);
#pragma unroll
    for (int r = 0; r < 16; ++r) p1[r] = fmaf(p1[r], C, mnC);
#pragma unroll
    for (int r = 0; r < 16; ++r) p0[r] = __builtin_amdgcn_exp2f(p0[r]);
}
DI void finishSM(f32x16& p0, f32x16& p1, float alpha, float& l_reg, bf16x8& pa0, bf16x8& pa1, bf16x8& pa2, bf16x8& pa3) {
#pragma unroll
    for (int r = 0; r < 16; ++r) p1[r] = __builtin_amdgcn_exp2f(p1[r]);
    float ps = 0;
#pragma unroll
    for (int r = 0; r < 16; ++r) ps += p0[r];
#pragma unroll
    for (int r = 0; r < 16; ++r) ps += p1[r];
    { auto rr = __builtin_amdgcn_permlane32_swap(__float_as_uint(ps), __float_as_uint(ps), false, false);
      ps = __uint_as_float(rr[0]) + __uint_as_float(rr[1]); }
    l_reg = l_reg * alpha + ps;
#define PK4(P, BASE, OUT) do { unsigned a0 = pk2(P[BASE + 0], P[BASE + 1]), a1 = pk2(P[BASE + 2], P[BASE + 3]);   \
    unsigned b0 = pk2(P[BASE + 4], P[BASE + 5]), b1 = pk2(P[BASE + 6], P[BASE + 7]);                              \
    auto r0 = __builtin_amdgcn_permlane32_swap(a0, b0, false, false); auto r1 = __builtin_amdgcn_permlane32_swap(a1, b1, false, false); \
    u32x4 w = {r0[0], r1[0], r0[1], r1[1]}; OUT = __builtin_bit_cast(bf16x8, w); } while (0)
    PK4(p0, 0, pa0); PK4(p0, 8, pa1); PK4(p1, 0, pa2); PK4(p1, 8, pa3);
#undef PK4
}
template <int KIND>
DI void qkt(f32x16& p0, f32x16& p1, const char* Ks, const char* Krs, const bf16x8* qr, const LAS char* qrope, int r32, int hi) {
    p0 = f32x16{}; p1 = f32x16{};
#pragma unroll
    for (int d0 = 0; d0 < 8; ++d0) { const int cb = (d0 * 16 + hi * 8) * 2;
        const bf16x8 b0 = *reinterpret_cast<const bf16x8*>(Ks + KSWZ(r32, cb));
        const bf16x8 b1 = *reinterpret_cast<const bf16x8*>(Ks + KSWZ(32 + r32, cb));
        p0 = __builtin_amdgcn_mfma_f32_32x32x16_bf16(b0, qr[d0], p0, 0, 0, 0);
        p1 = __builtin_amdgcn_mfma_f32_32x32x16_bf16(b1, qr[d0], p1, 0, 0, 0); }
    if constexpr (KIND == 0) {
#pragma unroll
        for (int d0 = 0; d0 < 4; ++d0) { const int cb = (d0 * 16 + hi * 8) * 2;
            const bf16x8 b0 = *reinterpret_cast<const bf16x8*>(Krs + KRSWZ(r32, cb));
            const bf16x8 b1 = *reinterpret_cast<const bf16x8*>(Krs + KRSWZ(32 + r32, cb));
            const bf16x8 qq = *reinterpret_cast<const LAS bf16x8*>(qrope + d0 * 1024);
            p0 = __builtin_amdgcn_mfma_f32_32x32x16_bf16(b0, qq, p0, 0, 0, 0);
            p1 = __builtin_amdgcn_mfma_f32_32x32x16_bf16(b1, qq, p1, 0, 0, 0); }
    }
}
DI void na_fix(f32x16& p0, f32x16& p1, int j, const NaInfo& na, const float C, int qc, int hi) {
    const float NEGM = -3.0e38f;
    if (j >= na.nloc) {
        const bool dummy = false;
#pragma unroll
        for (int r = 0; r < 16; ++r) { p0[r] *= C; p1[r] *= C; }
        (void)dummy; return;
    }
    const int kr = na.lo + j, q = na.qrow;
    const int rs = q - 4 < 0 ? 0 : (q - 4 > 56 ? 56 : q - 4);
    const bool rowin = (kr >= rs) && (kr < rs + 8);
    const int dr = kr - q + 7;
    const int cs = qc - 8 < 0 ? 0 : (qc - 8 > 48 ? 48 : qc - 8);
    const LAS float* bt = na.rpb + (rowin ? dr : 0) * 31 + 15;
#pragma unroll
    for (int r = 0; r < 16; ++r) {
        { const int kc = crow(r, hi); int dc = kc - qc; dc = dc < -15 ? -15 : (dc > 15 ? 15 : dc);
          const bool ok = rowin && kc >= cs && kc < cs + 16; p0[r] = ok ? fmaf(p0[r], C, bt[dc]) : NEGM; }
        { const int kc = 32 + crow(r, hi); int dc = kc - qc; dc = dc < -15 ? -15 : (dc > 15 ? 15 : dc);
          const bool ok = rowin && kc >= cs && kc < cs + 16; p1[r] = ok ? fmaf(p1[r], C, bt[dc]) : NEGM; }
    }
}
DI int v_st(int k, int c) { const int kk = (k & ~0xC) | ((k & 4) << 1) | ((k & 8) >> 1); return ((kk >> 3) * 4 + (c >> 5)) * 512 + ((kk & 7) * 32 + (c & 31)) * 2; }
DI int v_rd_base(int lane) { return ((lane & 3) << 3) | (((lane >> 2) & 3) << 6) | (((lane >> 4) & 1) << 5) | (((lane >> 5) & 1) << 8); }
constexpr int v_rd_off(int d0, int ks, int half) { return d0 * 512 + ks * 4096 + half * 2048; }
template <int OFF> DI s16x4 tr_read(int vb) { s16x4 r; asm volatile("ds_read_b64_tr_b16 %0, %1 offset:%2" : "=&v"(r) : "v"(vb), "i"(OFF) : "memory"); return r; }
template <int D0> DI void pv_one(f32x16& od, int vb, bf16x8 pa0, bf16x8 pa1, bf16x8 pa2, bf16x8 pa3) {
    const s16x4 l0 = tr_read<v_rd_off(D0, 0, 0)>(vb), h0 = tr_read<v_rd_off(D0, 0, 1)>(vb), l1 = tr_read<v_rd_off(D0, 1, 0)>(vb), h1 = tr_read<v_rd_off(D0, 1, 1)>(vb);
    const s16x4 l2 = tr_read<v_rd_off(D0, 2, 0)>(vb), h2 = tr_read<v_rd_off(D0, 2, 1)>(vb), l3 = tr_read<v_rd_off(D0, 3, 0)>(vb), h3 = tr_read<v_rd_off(D0, 3, 1)>(vb);
    asm volatile("s_waitcnt lgkmcnt(0)" ::: "memory"); SBAR();
#define PK(L, H) (bf16x8){L[0], L[1], L[2], L[3], H[0], H[1], H[2], H[3]}
    od = __builtin_amdgcn_mfma_f32_32x32x16_bf16(pa0, PK(l0, h0), od, 0, 0, 0);
    od = __builtin_amdgcn_mfma_f32_32x32x16_bf16(pa1, PK(l1, h1), od, 0, 0, 0);
    od = __builtin_amdgcn_mfma_f32_32x32x16_bf16(pa2, PK(l2, h2), od, 0, 0, 0);
    od = __builtin_amdgcn_mfma_f32_32x32x16_bf16(pa3, PK(l3, h3), od, 0, 0, 0);
#undef PK
}
DI void pv_d0(f32x16* o, int vb, bf16x8 pa0, bf16x8 pa1, bf16x8 pa2, bf16x8 pa3) {
    pv_one<0>(o[0], vb, pa0, pa1, pa2, pa3); pv_one<1>(o[1], vb, pa0, pa1, pa2, pa3); pv_one<2>(o[2], vb, pa0, pa1, pa2, pa3); pv_one<3>(o[3], vb, pa0, pa1, pa2, pa3);
}

template <int KIND>
DI void attn_unit(const bf16_t* __restrict__ Qb, int ldq, bf16_t* __restrict__ Ob, int ldo, const Src src, int NT, const float scale, const NaInfo na, const QPrep qp, char* lds) {
    int tid_ = threadIdx.x; asm volatile("" : "+v"(tid_));
    const int tid = tid_, wid = __builtin_amdgcn_readfirstlane(tid >> 6), lane = tid & 63, r32 = lane & 31, hi = lane >> 5;
    char* V_lds = lds + OFF_V; char* K_lds = lds + OFF_K; char* KR_lds = lds + OFF_KR;
    float* ws = (float*)(lds + OFF_WS) + wid * 64; float* li_l = ws; float* al_l = ws + 32;
    const LAS char* qrope = (const LAS char*)(lds + OFF_QR + wid * 4096 + lane * 16);
    const float C = (KIND == 2) ? 1.0f : scale * LOG2E;
    const float CN = scale * LOG2E;
    const float thr_raw = (KIND == 2) ? THR * LOG2E : THR / scale;
    float m_reg = -1e30f, l_reg = 0; f32x16 o[4] = {}; bf16x8 qr[8];
    const bf16_t* Qw = Qb + (size_t)(wid * QBLK + r32) * ldq + hi * 8;
    {
        u32x4 raw[KIND == 0 ? 12 : 8];
#pragma unroll
        for (int d0 = 0; d0 < (KIND == 0 ? 12 : 8); ++d0) raw[d0] = *reinterpret_cast<const u32x4*>(Qw + d0 * 16);
        float ss = 0.f;
#pragma unroll
        for (int d0 = 0; d0 < (KIND == 0 ? 12 : 8); ++d0) { float e[8]; unpack8(raw[d0], e);
#pragma unroll
            for (int j = 0; j < 8; ++j) ss += e[j] * e[j]; }
        { auto rr = __builtin_amdgcn_permlane32_swap(__float_as_uint(ss), __float_as_uint(ss), false, false); ss = __uint_as_float(rr[0]) + __uint_as_float(rr[1]); }
        const float ri = rsqrtf(ss * (KIND == 0 ? (1.0f / 192.0f) : (1.0f / 128.0f)) + EPS);
#pragma unroll
        for (int d0 = 0; d0 < 8; ++d0) { float e[8]; unpack8(raw[d0], e);
            const f32x4 g0 = *(const f32x4*)(qp.gain + d0 * 16 + hi * 8), g1 = *(const f32x4*)(qp.gain + d0 * 16 + hi * 8 + 4);
#pragma unroll
            for (int j = 0; j < 4; ++j) { e[j] = e[j] * ri * g0[j]; e[4 + j] = e[4 + j] * ri * g1[j]; }
            const u32x4 w = pack8f(e); qr[d0] = __builtin_bit_cast(bf16x8, w); }
        if constexpr (KIND == 0) {
            float y[4][8];
#pragma unroll
            for (int d0 = 0; d0 < 4; ++d0) { unpack8(raw[8 + d0], y[d0]);
                const f32x4 g0 = *(const f32x4*)(qp.gain + 128 + d0 * 16 + hi * 8), g1 = *(const f32x4*)(qp.gain + 128 + d0 * 16 + hi * 8 + 4);
#pragma unroll
                for (int j = 0; j < 4; ++j) { y[d0][j] = y[d0][j] * ri * g0[j]; y[d0][4 + j] = y[d0][4 + j] * ri * g1[j]; } }
            if (qp.rope) { const int t = qp.tok0 + wid * QBLK + r32;
#pragma unroll
                for (int pr = 0; pr < 2; ++pr) { const int pos = pr == 0 ? (t >> 6) : (t & 63);
                    const f32x4 c0 = *(const f32x4*)(qp.rope + pos * 16 + hi * 8), c1 = *(const f32x4*)(qp.rope + pos * 16 + hi * 8 + 4);
                    const f32x4 s0 = *(const f32x4*)(qp.rope + 1024 + pos * 16 + hi * 8), s1 = *(const f32x4*)(qp.rope + 1024 + pos * 16 + hi * 8 + 4);
#pragma unroll
                    for (int j = 0; j < 8; ++j) { const float cc = j < 4 ? c0[j & 3] : c1[j & 3], sn = j < 4 ? s0[j & 3] : s1[j & 3];
                        const float x1 = y[2 * pr][j], x2 = y[2 * pr + 1][j];
                        y[2 * pr][j] = x1 * cc - x2 * sn; y[2 * pr + 1][j] = x1 * sn + x2 * cc; } } }
#pragma unroll
            for (int d0 = 0; d0 < 4; ++d0) { const u32x4 w = pack8f(y[d0]); *(LAS u32x4*)(lds + OFF_QR + wid * 4096 + lane * 16 + d0 * 1024) = w; }
        }
    }
    const int qc = (wid & 1) * 32 + r32;
    const int vb0 = (int)(uintptr_t)(LAS char*)(V_lds) + v_rd_base(lane);
    int kofs[2], vrow[2], vcol[2], krofs;
#pragma unroll
    for (int i = 0; i < 2; ++i) { const int sl = tid + 512 * i;
        { const int row = sl >> 4, cch = (sl & 15) ^ (row & 7); kofs[i] = (row << 16) | (cch * 8); }
        { const int sub = sl >> 5, w = sl & 31, kk = (sub >> 2) * 8 + (w >> 2); vrow[i] = (kk & ~0xC) | ((kk & 4) << 1) | ((kk & 8) >> 1); vcol[i] = (sub & 3) * 32 + (w & 3) * 8; } }
    { const int row = tid >> 3, cch = (tid & 7) ^ (row & 7); krofs = (row << 16) | (128 + cch * 8); }
    const unsigned slot0 = (unsigned)wid * 1024u;
#define SDMA(jt, bb) do { const bf16_t *kp_, *vp_; int ldk_, ldv_; src.get((jt), kp_, vp_, ldk_, ldv_); \
    _Pragma("unroll") for (int i_ = 0; i_ < 2; ++i_) { \
        __builtin_amdgcn_global_load_lds((const unsigned*)(kp_ + (size_t)(kofs[i_] >> 16) * ldk_ + (kofs[i_] & 0xffff)), (LAS unsigned*)(K_lds + (bb) * SHM_K + slot0 + i_ * 8192), 16, 0, 0); \
        __builtin_amdgcn_global_load_lds((const unsigned*)(vp_ + (size_t)vrow[i_] * ldv_ + vcol[i_]), (LAS unsigned*)(V_lds + (bb) * SHM_V + slot0 + i_ * 8192), 16, 0, 0); } \
    if constexpr (KIND == 0) __builtin_amdgcn_global_load_lds((const unsigned*)(kp_ + (size_t)(krofs >> 16) * ldk_ + (krofs & 0xffff)), (LAS unsigned*)(KR_lds + (bb) * SHM_KR + slot0), 16, 0, 0); } while (0)
    SDMA(0, 0); asm volatile("s_waitcnt vmcnt(0)" ::: "memory");
#pragma unroll
    for (int d0 = 0; d0 < 8; ++d0) asm volatile("" : "+v"(qr[d0]));
    __syncthreads();
    for (int j = 0; j < NT; ++j) {
        const int b = j & 1;
        f32x16 p0, p1; float mn, al; bf16x8 pa0, pa1, pa2, pa3;
        if (j + 1 < NT) SDMA(j + 1, b ^ 1);
        SBAR();
        bool skip = false;
        if constexpr (KIND == 2) { if (j < na.nloc) { const int kr = na.lo + j, q_ = na.qrow; const int rs_ = q_ - 4 < 0 ? 0 : (q_ - 4 > 56 ? 56 : q_ - 4); skip = !(kr >= rs_ && kr < rs_ + 8); } }
        if (!skip) {
        qkt<KIND>(p0, p1, K_lds + b * SHM_K, KR_lds + b * SHM_KR, qr, qrope, r32, hi);
        if constexpr (KIND == 2) na_fix(p0, p1, j, na, CN, qc, hi);
        partialSM(p0, p1, m_reg, mn, al, C, thr_raw);
        if (__any(al < 1.f)) { if (hi == 0) al_l[r32] = al; asm volatile("s_waitcnt lgkmcnt(0)" ::: "memory");
#pragma unroll
            for (int d = 0; d < 4; ++d)
#pragma unroll
                for (int r = 0; r < 16; ++r) o[d][r] *= al_l[crow(r, hi)]; }
        finishSM(p0, p1, al, l_reg, pa0, pa1, pa2, pa3); SBAR();
        pv_d0(o, vb0 + b * SHM_V, pa0, pa1, pa2, pa3);
        }
        asm volatile("s_waitcnt vmcnt(0)" ::: "memory");
        __syncthreads();
    }
    if (hi == 0) li_l[r32] = l_reg; asm volatile("s_waitcnt lgkmcnt(0)" ::: "memory");
    float rli[16];
#pragma unroll
    for (int r = 0; r < 16; ++r) rli[r] = __builtin_amdgcn_rcpf(li_l[crow(r, hi)]);
    bf16_t* Ow = Ob + (size_t)(wid * QBLK) * ldo;
#pragma unroll
    for (int r = 0; r < 16; ++r) { const int orow = crow(r, hi);
#pragma unroll
        for (int d0 = 0; d0 < 4; ++d0) Ow[(size_t)orow * ldo + d0 * 32 + r32] = f2bf(o[d0][r] * rli[r]); }
    asm volatile("s_waitcnt vmcnt(0) lgkmcnt(0)" ::: "memory");
    __syncthreads();
#undef SDMA
}
}
namespace hg {
DI int crow(int r, int hi) { return (r & 3) + 8 * (r >> 2) + 4 * hi; }
DI bf16x8 pack8(const f32x16& x, int s) {
    u32x4 w; w.x = pk2(x[8 * s + 0], x[8 * s + 1]); w.y = pk2(x[8 * s + 2], x[8 * s + 3]); w.z = pk2(x[8 * s + 4], x[8 * s + 5]); w.w = pk2(x[8 * s + 6], x[8 * s + 7]);
    return __builtin_bit_cast(bf16x8, w);
}
DI bf16x8 ldperm(const bf16_t* rowp, int kk, int hh) {
    const u32x2 a = *(const u32x2*)(rowp + 16 * kk + 4 * hh), b = *(const u32x2*)(rowp + 16 * kk + 8 + 4 * hh);
    u32x4 w = {a.x, a.y, b.x, b.y}; return __builtin_bit_cast(bf16x8, w);
}
#define HMFMA(a, b, c) __builtin_amdgcn_mfma_f32_32x32x16_bf16((a), (b), (c), 0, 0, 0)

constexpr int CH_QT = 0, CH_KT = 8192, CH_KTT = 16384, CH_VT = 24576, CH_EV = 32768, CH_BYTES = 33792, CH_STAGE = 2 * CH_BYTES;
DI bf16x8 lds_perm16(const LAS char* row, int kk, int hh, int swz) {
    const u32x2 a = *(const LAS u32x2*)(row + (((2 * kk) ^ swz) << 4) + 8 * hh), b = *(const LAS u32x2*)(row + (((2 * kk + 1) ^ swz) << 4) + 8 * hh);
    u32x4 w = {a.x, a.y, b.x, b.y}; return __builtin_bit_cast(bf16x8, w);
}
DI void chain_stage(PkPtr p, LAS unsigned char* sb, int dir, int wv, int lane, size_t u) {
    const unsigned char* HG = (const unsigned char*)p->ws + WS_HG;
    const char* gq = (const char*)(HG + (dir ? HG_QTB : HG_QTF)) + u * 8192;
    const char* gk = (const char*)(HG + (dir ? HG_KTB : HG_KTF)) + u * 8192;
    const char* gt = (const char*)(HG + (dir ? HG_KTTB : HG_KTTF)) + u * 8192;
    const char* gv = (const char*)(HG + HG_VT) + u * 8192;
#pragma unroll
    for (int j = 0; j < 2; ++j) {
        const int pi = wv * 64 + lane + 256 * j;
        const int r16 = pi >> 4, c16 = (pi & 15) ^ (r16 & 15);
        const int r4 = pi >> 2, c4 = (pi & 3) ^ ((r4 >> 2) & 3);
        const unsigned lo = (unsigned)(wv * 64 + 256 * j) * 16u;
        __builtin_amdgcn_global_load_lds((const unsigned*)(gq + r16 * 256 + c16 * 16), (LAS unsigned*)(sb + CH_QT + lo), 16, 0, 0);
        __builtin_amdgcn_global_load_lds((const unsigned*)(gk + r16 * 256 + c16 * 16), (LAS unsigned*)(sb + CH_KT + lo), 16, 0, 0);
        __builtin_amdgcn_global_load_lds((const unsigned*)(gt + r4 * 64 + c4 * 16), (LAS unsigned*)(sb + CH_KTT + lo), 16, 0, 0);
        __builtin_amdgcn_global_load_lds((const unsigned*)(gv + r4 * 64 + c4 * 16), (LAS unsigned*)(sb + CH_VT + lo), 16, 0, 0);
    }
    if (wv == 0) { const char* ge = (const char*)(HG + HG_EV) + u * 2048 + dir * 1024;
        __builtin_amdgcn_global_load_lds((const unsigned*)(ge + lane * 16), (LAS unsigned*)(sb + CH_EV), 16, 0, 0); }
}
DI void chain_unit(PkPtr p, LAS unsigned char* lds, int l, bool lat, int b, int h, int tid_) {
    int tid = tid_; asm volatile("" : "+v"(tid));
    const int lane = tid & 63, wid = __builtin_amdgcn_readfirstlane(tid >> 6), dir = wid >> 2, vs = wid & 3;
    const int r = lane & 31, hh = lane >> 5;
    const int tok0 = lat ? NTC + b * 4096 : b * 256, nch = lat ? 128 : 8;
    bf16_t* Z = (bf16_t*)((unsigned char*)p->ws + WS_Z);
    f32x16 S[4];
    if (lat) { const float* s0 = (const float*)p->in[I_SHG] + ((((size_t)b * 4 + l) * 2 + dir) * 8 + h) * (128 * 128) + 32 * vs + r;
#pragma unroll
        for (int kb = 0; kb < 4; ++kb)
#pragma unroll
            for (int i = 0; i < 16; ++i) S[kb][i] = s0[(size_t)(32 * kb + crow(i, hh)) * 128];
    } else {
#pragma unroll
        for (int kb = 0; kb < 4; ++kb) S[kb] = f32x16{};
    }
    const size_t ubase = (size_t)(tok0 / 32) * 8 + h;
    chain_stage(p, lds + dir * CH_BYTES, dir, vs, lane, ubase + (size_t)(dir ? nch - 1 : 0) * 8);
    asm volatile("s_waitcnt vmcnt(0)" ::: "memory"); __syncthreads();
    for (int cc = 0; cc < nch; ++cc) {
        const int ci = dir ? nch - 1 - cc : cc;
        if (cc + 1 < nch) chain_stage(p, lds + ((cc + 1) & 1) * CH_STAGE + dir * CH_BYTES, dir, vs, lane, ubase + (size_t)(dir ? ci - 1 : ci + 1) * 8);
        const LAS char* sb = (const LAS char*)(lds + (cc & 1) * CH_STAGE + dir * CH_BYTES);
        const LAS float* EV = (const LAS float*)(sb + CH_EV);
        const LAS char* qrow = sb + CH_QT + r * 256; const LAS char* krow = sb + CH_KT + r * 256; const int sw16 = r & 15;
        f32x16 pT = f32x16{}, o = f32x16{};
#pragma unroll
        for (int kb = 0; kb < 4; ++kb) {
            const LAS f32x4* e = (const LAS f32x4*)(EV + kb * 32 + hh * 16);
            const f32x4 e0 = e[0], e1 = e[1], e2 = e[2], e3 = e[3];
            const bf16x8 q0 = lds_perm16(qrow, 2 * kb, hh, sw16), k0 = lds_perm16(krow, 2 * kb, hh, sw16);
            const bf16x8 q1 = lds_perm16(qrow, 2 * kb + 1, hh, sw16), k1 = lds_perm16(krow, 2 * kb + 1, hh, sw16);
#pragma unroll
            for (int i = 0; i < 4; ++i) { S[kb][i] *= e0[i]; S[kb][4 + i] *= e1[i]; S[kb][8 + i] *= e2[i]; S[kb][12 + i] *= e3[i]; }
            const bf16x8 s0 = pack8(S[kb], 0), s1 = pack8(S[kb], 1);
            pT = HMFMA(k0, q0, pT); o = HMFMA(q0, s0, o);
            pT = HMFMA(k1, q1, pT); o = HMFMA(q1, s1, o);
            __builtin_amdgcn_sched_barrier(0);
        }
#pragma unroll
        for (int i = 0; i < 16; ++i) { const int s = crow(i, hh); const bool keep = dir ? (s >= r) : (s <= r); pT[i] = keep ? pT[i] : 0.f; }
        const int vr = 32 * vs + r, swv = (vr >> 2) & 3;
        const LAS char* vrow = sb + CH_VT + vr * 64;
        { const u32x2 a0 = *(const LAS u32x2*)(vrow + ((0 ^ swv) << 4) + 8 * hh), b0 = *(const LAS u32x2*)(vrow + ((1 ^ swv) << 4) + 8 * hh);
          const u32x2 a1 = *(const LAS u32x2*)(vrow + ((2 ^ swv) << 4) + 8 * hh), b1 = *(const LAS u32x2*)(vrow + ((3 ^ swv) << 4) + 8 * hh);
          const u32x4 w0 = {a0.x, a0.y, b0.x, b0.y}, w1 = {a1.x, a1.y, b1.x, b1.y};
          o = HMFMA(pack8(pT, 0), __builtin_bit_cast(bf16x8, w0), o);
          o = HMFMA(pack8(pT, 1), __builtin_bit_cast(bf16x8, w1), o); }
        { bf16_t* op = Z + (size_t)(tok0 + ci * 32) * LDZ + (dir ? ZC_OB : ZC_OF) + h * 128 + 32 * vs + r;
#pragma unroll
            for (int i = 0; i < 16; ++i) op[(size_t)crow(i, hh) * LDZ] = f2bf(o[i]); }
        __builtin_amdgcn_sched_barrier(0);
        const bf16x8 v0 = *(const LAS bf16x8*)(vrow + ((hh ^ swv) << 4)), v1 = *(const LAS bf16x8*)(vrow + (((2 + hh) ^ swv) << 4));
        const int swk = (r >> 2) & 3;
#pragma unroll
        for (int kb = 0; kb < 4; ++kb) {
            const LAS char* trow = sb + CH_KTT + (32 * kb + r) * 64;
            const bf16x8 a0 = *(const LAS bf16x8*)(trow + ((hh ^ swk) << 4)), a1 = *(const LAS bf16x8*)(trow + (((2 + hh) ^ swk) << 4));
            S[kb] = HMFMA(a0, v0, S[kb]); S[kb] = HMFMA(a1, v1, S[kb]);
            const LAS f32x4* e = (const LAS f32x4*)(EV + 128 + kb * 32 + hh * 16);
            const f32x4 e0 = e[0], e1 = e[1], e2 = e[2], e3 = e[3];
#pragma unroll
            for (int i = 0; i < 4; ++i) { S[kb][i] *= e0[i]; S[kb][4 + i] *= e1[i]; S[kb][8 + i] *= e2[i]; S[kb][12 + i] *= e3[i]; }
        }
        asm volatile("s_waitcnt vmcnt(0)" ::: "memory"); __syncthreads();
    }
    if (!lat) { float* so = (float*)p->out + O_HGS + ((((size_t)b * 4 + l) * 2 + dir) * 8 + h) * (128 * 128) + 32 * vs + r;
#pragma unroll
        for (int kb = 0; kb < 4; ++kb)
#pragma unroll
            for (int i = 0; i < 16; ++i) so[(size_t)(32 * kb + crow(i, hh)) * 128] = S[kb][i];
    }
    { bf16_t* OBR = (bf16_t*)((unsigned char*)p->ws + WS_OBR); const float* gg = (const float*)p->in[I_HGG] + l * 128;
      const int g4 = lane >> 4, li = lane & 15;
      float gv[8];
#pragma unroll
      for (int j = 0; j < 8; ++j) gv[j] = gg[8 * li + j];
      for (int rr = wid * 4 + g4; rr < nch * 32; rr += 32) {
          const bf16_t* zr = Z + (size_t)(tok0 + rr) * LDZ + h * 128 + 8 * li;
          float a[8], bb[8], x[8]; unpack8(*(const u32x4*)(zr + ZC_OF), a); unpack8(*(const u32x4*)(zr + ZC_OB), bb); unpack8(*(const u32x4*)(zr + ZC_HG), x);
          float s = 0.f;
#pragma unroll
          for (int j = 0; j < 8; ++j) { a[j] += bb[j]; s += a[j] * a[j]; }
          s = group16_sum(s); const float ri = rsqrtf(s * (1.0f / 128.0f) + EPS);
#pragma unroll
          for (int j = 0; j < 8; ++j) a[j] = a[j] * ri * gv[j] * (x[j] * sigmoidf_(x[j]));
          *(u32x4*)(OBR + (size_t)(tok0 + rr) * LDO + 1024 + h * 128 + 8 * li) = pack8f(a); } }
}
#undef HMFMA
}

DI void load_rpb(const Ctx& c, PkPtr p, int l, int h) {
    LAS float* T = (LAS float*)(c.lds + att::OFF_RPB);
    const float* s = ((const float*)p->in[I_RPB]) + ((size_t)l * 8 + h) * (15 * 31);
    for (int i = c.tid; i < 15 * 31; i += 512) T[i] = s[i] * att::LOG2E;
    __syncthreads();
}

constexpr int QW_BASE = 4096;
DI unsigned* qword(PkPtr p, int l, int cat, int q) { return (unsigned*)(((unsigned char*)p->ws) + WS_CTL) + QW_BASE + ((l * 6 + cat) * 8 + q) * 16; }
DI unsigned grab(unsigned* ctr, volatile LAS unsigned* slot, int tid) {
    __syncthreads();
    if (tid == 0) *slot = __hip_atomic_fetch_add(ctr, 1u, __ATOMIC_RELAXED, __HIP_MEMORY_SCOPE_AGENT);
    __syncthreads();
    return (unsigned)__builtin_amdgcn_readfirstlane((int)*slot);
}
DI unsigned peek8(unsigned* ctr0, unsigned n, volatile LAS unsigned* slot, int tid) {
    __syncthreads();
    if (tid < 64) { const unsigned v = tid < 8 ? __hip_atomic_load(ctr0 + 16 * tid, __ATOMIC_RELAXED, __HIP_MEMORY_SCOPE_AGENT) : n;
        const unsigned long long bm = __ballot(v < n); if (tid == 0) *slot = (unsigned)bm & 0xffu; }
    __syncthreads();
    return (unsigned)__builtin_amdgcn_readfirstlane((int)*slot);
}

#ifdef PROBE_MIXQ2
#define QREP 2u
#else
#define QREP 1u
#endif
#ifdef PROBE_MLAQ2
#define QREP1 2u
#else
#define QREP1 QREP
#endif
DI void phase_mixers(const Ctx& c0, PkPtr p, int l, int lq, int bg_first) {
    const Ctx c = launder(c0);
    bf16_t* Z = (bf16_t*)(((unsigned char*)p->ws) + WS_Z); const bf16_t* KB = (const bf16_t*)(((unsigned char*)p->ws) + WS_KBUF); const bf16_t* KV = (const bf16_t*)(((unsigned char*)p->ws) + WS_KVRAW);
    char* lds = (char*)c.lds; bf16_t* OBR = (bf16_t*)(((unsigned char*)p->ws) + WS_OBR);
    const float sc_mla = 0.07216878364870322f, sc_na = 0.08838834764831845f;
    att::NaInfo na0; na0.nloc = 0; na0.lo = 0; na0.qrow = 0; na0.rpb = (const LAS float*)(c.lds + att::OFF_RPB);
    const float* RT_ = (const float*)(((unsigned char*)p->ws) + WS_ROPE);
    const att::QPrep qp_mla_lat0{((const float*)p->in[I_QG]) + l * 192, RT_, 0}, qp_mla_ctx{((const float*)p->in[I_QG]) + l * 192, nullptr, 0}, qp_na{((const float*)p->in[I_NAQG]) + l * 128, nullptr, 0};
    volatile LAS unsigned* slot = (volatile LAS unsigned*)(c.lds + QSLOT_OFF);
    const int x = (int)(xb_xcc_id() & 7u);
#ifndef MIX_MASK
#define MIX_MASK 31
#endif
    if (MIX_MASK & 16) {
        int q = x;
        for (;;) {
            const unsigned u0 = grab(qword(p, lq, 0, q), slot, c.tid); const unsigned u = u0 & 3u;
            if (u0 < 4u * QREP) { const int v = q * 4 + (int)u; hg::chain_unit(p, c.lds, l, true, v >> 3, v & 7, c.tid); continue; }
            const unsigned m = peek8(qword(p, lq, 0, 0), 4u * QREP, slot, c.tid);
            if (!m) break;
            const unsigned rot = ((m >> x) | (m << (8 - x))) & 0xffu; q = (x + __builtin_ctz(rot)) & 7;
        }
    }
    if (MIX_MASK & 1) {
        int q = x;
        for (;;) {
            const unsigned u1 = grab(qword(p, lq, 1, q), slot, c.tid); const unsigned u = u1 & 63u;
            if (u1 < 64u * QREP1) {
                const int pair = q * 4 + (int)(u >> 4), blk = (int)(u & 15u);
                const int b = pair >> 3, h = pair & 7;
                const size_t qrow0 = (size_t)NTC + b * 4096 + blk * 256;
                att::Src s; s.k0 = KB + ((size_t)(NTC + b * 4096) * 8 + h) * 192; s.v0 = KV + (size_t)(NTC + b * 4096) * 2048 + 1024 + h * 128; s.ldk0 = 1536; s.ldv0 = 2048; s.n0 = 64;
                s.k1 = KB + ((size_t)(NTOK + b * 512) * 8 + h) * 192; s.v1 = KV + (size_t)(NTOK + b * 512) * 2048 + 1024 + h * 128; s.ldk1 = 1536; s.ldv1 = 2048; s.rowclamp = 1 << 20;
                att::QPrep qpl = qp_mla_lat0; qpl.tok0 = blk * 256;
                att::attn_unit<0>(Z + qrow0 * LDZ + ZC_MQ + h * 192, LDZ, OBR + qrow0 * LDO + h * 128, LDO, s, 72, sc_mla, na0, qpl, lds);
                continue;
            }
            const unsigned m = peek8(qword(p, lq, 1, 0), 64u * QREP1, slot, c.tid);
            if (!m) break;
            const unsigned rot = ((m >> x) | (m << (8 - x))) & 0xffu; q = (x + __builtin_ctz(rot)) & 7;
        }
    }
    if (MIX_MASK & 2) for (;;) {
        const unsigned u2 = grab(qword(p, lq, 2, 0), slot, c.tid); const unsigned u = u2 & 511u;
        if (u2 >= 512u * QREP) break;
        const int b = u >> 7, h = (u >> 4) & 7, blk = u & 15;
        load_rpb(c, p, l, h);
        const int r0 = blk * 4;
        const int lo = r0 - 4 < 0 ? 0 : (r0 - 4 > 56 ? 56 : r0 - 4);
        const int r3 = r0 + 3; const int rs3 = r3 - 4 < 0 ? 0 : (r3 - 4 > 56 ? 56 : r3 - 4);
        const int nloc = rs3 + 8 - lo, nlp = (nloc + 1) & ~1;
        const size_t qrow0 = (size_t)NTC + b * 4096 + blk * 256, krow0 = (size_t)NTC + b * 4096 + lo * 64;
        att::Src s; s.k0 = Z + krow0 * LDZ + ZC_NK + h * 128; s.v0 = Z + krow0 * LDZ + ZC_NV + h * 128; s.ldk0 = LDZ; s.ldv0 = LDZ; s.n0 = nlp;
        s.k1 = (const bf16_t*)(((unsigned char*)p->ws) + WS_NAKC) + ((size_t)(l * 4 + b) * 512) * 1024 + h * 128; s.v1 = (const bf16_t*)(((unsigned char*)p->ws) + WS_NAVC) + ((size_t)(l * 4 + b) * 512) * 1024 + h * 128; s.ldk1 = 1024; s.ldv1 = 1024;
        s.rowclamp = 63 - lo;
        att::NaInfo na; na.nloc = nlp; na.lo = lo; na.qrow = r0 + (c.wid >> 1); na.rpb = na0.rpb;
        att::attn_unit<2>(Z + qrow0 * LDZ + ZC_NQ + h * 128, LDZ, OBR + qrow0 * LDO + 2048 + h * 128, LDO, s, nlp + 8, sc_na, na, qp_na, lds);
    }
    if (MIX_MASK & 16) for (;;) {
        const unsigned u3 = grab(qword(p, lq, 3, 0), slot, c.tid); const unsigned u = u3 & 255u;
        if (u3 >= 256u * QREP) break;
        hg::chain_unit(p, c.lds, l, false, (int)(u >> 3), (int)(u & 7u), c.tid);
    }
    if (MIX_MASK & 4) for (;;) {
        const unsigned u4 = grab(qword(p, lq, 4, 0), slot, c.tid); const unsigned u = u4 & 255u;
        if (u4 >= 256u * QREP) break;
        const int b = u >> 3, h = u & 7; const size_t row0 = (size_t)b * 256;
        att::Src s; s.k0 = KB + (row0 * 8 + h) * 192; s.v0 = KV + row0 * 2048 + 1024 + h * 128; s.ldk0 = 1536; s.ldv0 = 2048; s.n0 = 4; s.k1 = s.k0; s.v1 = s.v0; s.ldk1 = 1536; s.ldv1 = 2048; s.rowclamp = 1 << 20;
        att::attn_unit<0>(Z + row0 * LDZ + ZC_MQ + h * 192, LDZ, OBR + row0 * LDO + h * 128, LDO, s, 4, sc_mla, na0, qp_mla_ctx, lds);
    }
    if (MIX_MASK & 8) for (;;) {
        const unsigned u5 = grab(qword(p, lq, 5, 0), slot, c.tid); const unsigned u = u5 & 255u;
        if (u5 >= 256u * QREP) break;
        const int b = u >> 3, h = u & 7; const size_t row0 = (size_t)b * 256;
        att::Src s; s.k0 = Z + row0 * LDZ + ZC_NK + h * 128; s.v0 = Z + row0 * LDZ + ZC_NV + h * 128; s.ldk0 = LDZ; s.ldv0 = LDZ; s.n0 = 4; s.k1 = s.k0; s.v1 = s.v0; s.ldk1 = LDZ; s.ldv1 = LDZ; s.rowclamp = 1 << 20;
        att::attn_unit<1>(Z + row0 * LDZ + ZC_NQ + h * 128, LDZ, OBR + row0 * LDO + 2048 + h * 128, LDO, s, 4, sc_na, na0, qp_na, lds);
    }
    {
        unsigned* cq = (unsigned*)(((unsigned char*)p->ws) + WS_CTL) + 12288 + lq * 16;
        const int nb0 = l == 0 ? (TRI_PER_LAYER - TRI_EARLY + 3) / 4 : 0, nb1 = l + 1 < DEPTH ? (TRI_PER_LAYER - bg_first + 3) / 4 : 0;
        for (;;) {
            const int u = (int)grab(cq, slot, c.tid);
            if (u >= nb0 + nb1) break;
            int t0, te;
            if (u < nb0) { t0 = TRI_EARLY + 4 * u; te = TRI_PER_LAYER; }
            else { t0 = (l + 1) * TRI_PER_LAYER + bg_first + 4 * (u - nb0); te = (l + 2) * TRI_PER_LAYER; }
            prologue_transposes(c, p, t0, 1, t0 + 4 < te ? t0 + 4 : te);
        }
    }
}
constexpr int NPH = 12;
constexpr int N_PHASES = 1 + DEPTH * NPH;
constexpr int LDS_BYTES = LDS_STAGE + 256;
static_assert(att::LDS_END <= LDS_STAGE && 2 * hg::CH_STAGE <= LDS_STAGE, "attention / chain LDS");
#ifndef MK_LAUNCH_MODE
#define MK_LAUNCH_MODE 1
#endif

__global__ void __launch_bounds__(512, 2) mk_fwd(ParamsH p) {
    extern __shared__ __attribute__((aligned(16))) unsigned char lds_raw[];
    Ctx c; c.lds = (LAS unsigned char*)lds_raw; c.tid = threadIdx.x; c.lane = c.tid & 63; c.wid = __builtin_amdgcn_readfirstlane(c.tid >> 6); c.G = gridDim.x; c.bid = blockIdx.x;
    volatile LAS unsigned* bw = (volatile LAS unsigned*)(c.lds + LDS_STAGE);
    if (c.tid < 4) bw[c.tid] = 0u;
    __syncthreads();
    const PkPtr pk = (PkPtr)__builtin_amdgcn_kernarg_segment_ptr();
#define P_ (lp(pk))
    if (p.ph_hi - p.ph_lo > 1) (void)xcd_barrier_post((unsigned*)(((unsigned char*)P_->ws) + WS_CTL), bw);
#ifdef PROBE_THIN2
#define NREP_THIN (P_->ph_hi > 1000 ? 1 : 2)
#else
#define NREP_THIN 1
#endif
#ifdef PROBE_TR2
#define NREP_TR (P_->ph_hi > 1000 ? 1 : 2)
#else
#define NREP_TR 1
#endif
#ifdef PROBE_KPE2
#define NREP_KPE (P_->ph_hi > 1000 ? 1 : 2)
#else
#define NREP_KPE 1
#endif
#ifdef PROBE_G2
#define NREP_G2 (P_->ph_hi > 1000 ? 1 : 2)
#else
#define NREP_G2 1
#endif
#ifdef PROBE_MIX2
#define NREP_MIX (P_->ph_hi > 1000 ? 1 : 2)
#else
#define NREP_MIX 1
#endif
#ifdef PROBE_BAR2
#define SEAM_EXTRA if (P_->ph_hi < 1000) { xcd_barrier(bar_); }
#else
#define SEAM_EXTRA
#endif
#ifndef BG_UP
#define BG_UP 16
#endif
#ifndef BG_KV
#define BG_KV 2
#endif
#ifndef PH_MASK
#define PH_MASK 0xFFFFFFFF
#endif
#define EN(b) ((PH_MASK >> (b)) & 1)
#define IN(k) (P_->ph_lo <= (k) && (k) < P_->ph_hi)
#define SEAM(k) do { if (IN((k) + 1)) { XcdBarrier bar_; bar_.bar = (unsigned*)(((unsigned char*)P_->ws) + WS_CTL); bar_.x = xb_xcc_id(); bar_.st = (volatile LAS unsigned*)(c.lds + LDS_STAGE); xcd_barrier(bar_); SEAM_EXTRA } } while (0)

    if (EN(0) && IN(0)) {
        for (int rr = 0; rr < NREP_THIN; ++rr) {
        for (int r2 = 0; r2 < NREP_TR; ++r2) { prologue_transposes(c, P_, c.bid, c.G, TRI_EARLY); __syncthreads(); }
        prologue_modulation(c, P_); __syncthreads();
        prologue_misc(c, P_); __syncthreads(); }
        SEAM(0);
    }
    const int BG_NUP = ((NTOK / 256) * (FFN2 / 256)) % c.G ? c.G - ((NTOK / 256) * (FFN2 / 256)) % c.G : 0, BG_NKV = ((NKV / 256) * 8) % c.G ? c.G - ((NKV / 256) * 8) % c.G : 0;
    for (int l = 0; l < DEPTH; ++l) {
        const int pb = 1 + l * NPH;
#define wl (((unsigned char*)P_->ws) + WS_WT + (size_t)(l & 1) * WL_BYTES)
#define MODL ((const float*)(((unsigned char*)P_->ws) + WS_MOD) + (size_t)l * 5 * 6 * DM)
#define H ((bf16_t*)(((unsigned char*)P_->ws) + WS_H))
#define Z ((bf16_t*)(((unsigned char*)P_->ws) + WS_Z))
        if (EN(1) && IN(pb + 0)) { for (int rr = 0; rr < NREP_THIN; ++rr) phase_norm(c, P_, l, l == 0, ((const float*)P_->in[I_N1G]) + (size_t)l * DM, 0, 1);
            SEAM(pb + 0); }
        if (EN(2) && IN(pb + 1)) {
            pg8::Gemm g{H, (const bf16_t*)(wl + WL_IN), NTOK, NZ, DM, DM}; pg8::StaticOrder S; S.init(NTOK, NZ, c.G, c.bid);
            pg8::EpiStoreBf16 E{Z, LDZ};
            pg8::gemm_phase(c.lds, g, S, E);
            phase_kpe(c, P_, l);
#ifdef PROBE_GEMM2
            pg8::gemm_phase(c.lds, g, S, E);
#endif
            SEAM(pb + 1);
        }
        if (EN(3) && IN(pb + 2)) { phase_prep_tokens(c, P_, l); __syncthreads(); for (int rr = 0; rr < NREP_THIN; ++rr) { phase_prep_hgrn(c, P_, l); __syncthreads(); } SEAM(pb + 2); }
        if (EN(4) && IN(pb + 3)) {
            pg8::Gemm g{(const bf16_t*)(((unsigned char*)P_->ws) + WS_CKVN), (const bf16_t*)(wl + WL_KV), NKV, 2048, 512, 512}; pg8::StaticOrder S; S.init(NKV, 2048, c.G, c.bid);
            pg8::EpiStoreBf16T<false> E{(bf16_t*)(((unsigned char*)P_->ws) + WS_KVRAW), 2048};
            for (int rr = 0; rr < NREP_G2; ++rr) pg8::gemm_phase(c.lds, g, S, E);
            if (l + 1 < DEPTH && c.bid >= c.G - BG_NKV) { __syncthreads(); prologue_transposes(c, P_, (l + 1) * TRI_PER_LAYER + BG_UP * BG_NUP + (c.bid - (c.G - BG_NKV)), BG_NKV, (l + 1) * TRI_PER_LAYER + BG_UP * BG_NUP + BG_KV * BG_NKV); }
            SEAM(pb + 3);
        }
        if (EN(5) && IN(pb + 4)) { for (int rr = 0; rr < NREP_THIN; ++rr) phase_kfinal(c, P_, l); SEAM(pb + 4); }
        if (EN(6) && IN(pb + 5)) { for (int rr = 0; rr < NREP_MIX; ++rr) phase_mixers(c, P_, l, l + 4 * rr, BG_UP * BG_NUP + BG_KV * BG_NKV); SEAM(pb + 5); }
        if (EN(8) && IN(pb + 6)) {
            pg8::StaticOrder S; S.init(NTOK, DM, c.G, c.bid);
            pg8::Gemm g{(const bf16_t*)(((unsigned char*)P_->ws) + WS_OBR), (const bf16_t*)(wl + WL_BR), NTOK, DM, 3072, LDO}; pg8::EpiGate3 E{Z + ZC_GA, LDZ, H};
            for (int rr = 0; rr < NREP_G2; ++rr) pg8::gemm_phase(c.lds, g, S, E);
            SEAM(pb + 6);
        }
        if (EN(9) && IN(pb + 7)) {
            pg8::Gemm g{H, (const bf16_t*)(wl + WL_OUT), NTOK, DM, DM, DM}; pg8::StaticOrder S; S.init(NTOK, DM, c.G, c.bid);
            pg8::EpiResid E{((const float*)P_->in[I_XP]), ((const float*)P_->in[I_XS]), (bf16_t*)(((unsigned char*)P_->ws) + WS_XB), ((float*)P_->out), MODL + 2 * DM, l == 0 ? 1 : 0, 0};
            pg8::gemm_phase(c.lds, g, S, E);
            SEAM(pb + 7);
        }
        if (EN(10) && IN(pb + 8)) { for (int rr = 0; rr < NREP_THIN; ++rr) phase_norm(c, P_, l, false, ((const float*)P_->in[I_N2G]) + (size_t)l * DM, 3, 4); SEAM(pb + 8); }
        if (EN(11) && IN(pb + 9)) {
            pg8::Gemm g{H, (const bf16_t*)(wl + WL_UP), NTOK, FFN2, DM, DM}; pg8::StaticOrder S; S.init(NTOK, FFN2, c.G, c.bid);
            pg8::EpiConvAct E{(bf16_t*)(((unsigned char*)P_->ws) + WS_ACT), ((const float*)P_->in[I_CONVW]) + (size_t)l * 3 * FFN, ((const float*)P_->in[I_CONVB]) + (size_t)l * FFN, (float*)(((unsigned char*)P_->ws) + WS_EDGE)};
            pg8::gemm_phase(c.lds, g, S, E);
            if (l + 1 < DEPTH && c.bid >= c.G - BG_NUP) { __syncthreads(); prologue_transposes(c, P_, (l + 1) * TRI_PER_LAYER + (c.bid - (c.G - BG_NUP)), BG_NUP, (l + 1) * TRI_PER_LAYER + BG_UP * BG_NUP); }
            SEAM(pb + 9);
        }
        if (EN(12) && IN(pb + 10)) { phase_conv_fix(c, P_, l); SEAM(pb + 10); }
        if (EN(13) && IN(pb + 11)) {
            pg8::Gemm g{(const bf16_t*)(((unsigned char*)P_->ws) + WS_ACT), (const bf16_t*)(wl + WL_DN), NTOK, DM, FFN, FFN}; pg8::StaticOrder S; S.init(NTOK, DM, c.G, c.bid);
            pg8::EpiResid E{((const float*)P_->in[I_XP]), ((const float*)P_->in[I_XS]), (bf16_t*)(((unsigned char*)P_->ws) + WS_XB), ((float*)P_->out), MODL + 5 * DM, 0, l + 1 == DEPTH ? 1 : 0};
            pg8::gemm_phase(c.lds, g, S, E);
            if (l + 1 < DEPTH) SEAM(pb + 11);
        }
    }
#undef IN
#undef SEAM
#undef P_
#undef wl
#undef MODL
#undef H
#undef Z
}

extern "C" void kernel_launch(void* const* d_in, const int* in_sizes, int n_in, void* d_out, int out_size, void* d_ws, size_t ws_size, hipStream_t stream) {
    static int grid = 0;
    if (grid == 0) {
        if (n_in != 30 || (size_t)out_size != O_END || ws_size < WS_END) { fprintf(stderr, "kernel_launch: unexpected shapes (n_in %d out %d ws %zu need %zu)\n", n_in, out_size, ws_size, (size_t)WS_END); grid = -1; return; }
        int dev = 0, cus = 0, per_cu = 0;
        if (hipGetDevice(&dev) != hipSuccess || hipDeviceGetAttribute(&cus, hipDeviceAttributeMultiprocessorCount, dev) != hipSuccess) { grid = -1; return; }
        if (hipFuncSetAttribute((const void*)mk_fwd, hipFuncAttributeMaxDynamicSharedMemorySize, LDS_BYTES) != hipSuccess) { fprintf(stderr, "kernel_launch: hipFuncSetAttribute failed\n"); grid = -1; return; }
        if (hipOccupancyMaxActiveBlocksPerMultiprocessor(&per_cu, (const void*)mk_fwd, 512, LDS_BYTES) != hipSuccess || per_cu < 1) { fprintf(stderr, "kernel_launch: occupancy query says %d\n", per_cu); (void)hipGetLastError(); grid = -1; return; }
        grid = cus;
    }
    if (grid < 0) return;
    (void)hipMemsetAsync((char*)d_ws + WS_CTL, 0, CTL_BYTES, stream);
    ParamsH p{};
    for (int i = 0; i < 30; ++i) p.in[i] = (const float*)d_in[i];
    p.out = (float*)d_out; p.ws = (unsigned char*)d_ws;
#if MK_LAUNCH_MODE == 0
    for (int k = 0; k < N_PHASES; ++k) { p.ph_lo = k; p.ph_hi = k + 1; hipLaunchKernelGGL(mk_fwd, dim3(grid), dim3(512), LDS_BYTES, stream, p); }
#else
    p.ph_lo = 0; p.ph_hi = N_PHASES;
    hipLaunchKernelGGL(mk_fwd, dim3(grid), dim3(512), LDS_BYTES, stream, p);
#endif
    const hipError_t le = hipPeekAtLastError();
    if (le != hipSuccess) fprintf(stderr, "kernel_launch: launch failed: %s\n", hipGetErrorName(le));
}
```
